# Optimizing an MI355X kernel written in HIP

```python
import jax, jax.numpy as jnp
from jax import lax
import numpy as np

D_MODEL = 1024
BATCH = 4
SEQ = 8192
DEPTH = 1

N_META = 16
ATT_HEAD_DIM = 128
ATT_HEADS = D_MODEL // ATT_HEAD_DIM
ATT_WIDTH = ATT_HEADS * ATT_HEAD_DIM
LRU_WIDTH = D_MODEL
LRU_BLOCK_DIM = 64
LRU_BLOCKS = LRU_WIDTH // LRU_BLOCK_DIM
MIX_WIDTH = ATT_WIDTH + LRU_WIDTH
IN_WIDTH = 4 * ATT_WIDTH + 2 * LRU_WIDTH
CONV_WIDTH = 4
LRU_C = 8.0
Q_BLOCK = 128
RMS_EPS = 1e-6

kernel_name = "hymba_stickbreak_rglru_hybrid"


def rmsnorm(x, g):
    xf = x.astype(jnp.float32)
    y = xf * lax.rsqrt(jnp.mean(xf * xf, axis=-1, keepdims=True) + RMS_EPS)
    return (y * g.astype(jnp.float32)).astype(x.dtype)


def stick_breaking_attention(q, k, v):
    B, T, _ = q.shape
    pad = Q_BLOCK - N_META
    Tp = T + pad
    nb = Tp // Q_BLOCK
    scale = 1.0 / np.sqrt(ATT_HEAD_DIM).astype(np.float32)

    def to_heads(t):
        t = jnp.pad(t.astype(jnp.float32), ((0, 0), (pad, 0), (0, 0)))
        return t.reshape(B, Tp, ATT_HEADS, ATT_HEAD_DIM).transpose(0, 2, 1, 3)

    qh, kh, vh = to_heads(q), to_heads(k), to_heads(v)
    q_blocks = qh.reshape(B, ATT_HEADS, nb, Q_BLOCK, ATT_HEAD_DIM).transpose(2, 0, 1, 3, 4)
    kpos = jnp.arange(Tp)

    def one_block(args):
        i, qi = args
        qpos = i * Q_BLOCK + jnp.arange(Q_BLOCK)
        mask = (kpos[None, :] < qpos[:, None]) & (kpos[None, :] >= pad)
        z = jnp.einsum('bhqd,bhkd->bhqk', qi, kh) * scale
        log_beta = jax.nn.log_sigmoid(z)
        log_1m = jnp.where(mask, log_beta - z, 0.0)
        suffix = lax.cumsum(log_1m, axis=3, reverse=True) - log_1m
        w = jnp.where(mask, jnp.exp(log_beta + suffix), 0.0)
        return jnp.einsum('bhqk,bhkd->bhqd', w, vh)

    o = lax.map(one_block, (jnp.arange(nb), q_blocks))
    o = o.transpose(1, 0, 3, 2, 4).reshape(B, Tp, ATT_WIDTH)[:, pad:]
    return o.astype(q.dtype)


def rglru_branch(x, conv_w, conv_b, gate_a_w, gate_a_b, gate_x_w, gate_x_b, lru_lambda):
    B, T, _ = x.shape
    xp = jnp.pad(x, ((0, 0), (CONV_WIDTH - 1, 0), (0, 0)))
    xc = conv_b + sum(xp[:, j:j + T] * conv_w[j] for j in range(CONV_WIDTH))
    xb = xc.reshape(B, T, LRU_BLOCKS, LRU_BLOCK_DIM)
    r = jax.nn.sigmoid(jnp.einsum('btni,nij->btnj', xb, gate_a_w).reshape(B, T, LRU_WIDTH) + gate_a_b)
    i = jax.nn.sigmoid(jnp.einsum('btni,nij->btnj', xb, gate_x_w).reshape(B, T, LRU_WIDTH) + gate_x_b)
    log_a = (LRU_C * r.astype(jnp.float32)) * jax.nn.log_sigmoid(lru_lambda.astype(jnp.float32))
    a = jnp.exp(log_a)
    b = jnp.sqrt(-jnp.expm1(2.0 * log_a)) * (i * xc).astype(jnp.float32)

    def combine(left, right):
        a1, b1 = left
        a2, b2 = right
        return a1 * a2, a2 * b1 + b2

    _, h = lax.associative_scan(combine, (a, b), axis=1)
    return h.astype(x.dtype)


def hybrid_layer(h, pre_g, post_g, w_in, w_out, att_out_g, lru_out_g, conv_w, conv_b,
                 gate_a_w, gate_a_b, gate_x_w, gate_x_b, lru_lambda):
    u = rmsnorm(h, pre_g)
    p = u @ w_in
    A = ATT_WIDTH
    q, k, v, g_att, x_lru, g_lru = jnp.split(p, [A, 2 * A, 3 * A, 4 * A, 4 * A + LRU_WIDTH], axis=-1)
    att = rmsnorm(stick_breaking_attention(q, k, v), att_out_g) * jax.nn.silu(g_att)
    lru = rglru_branch(x_lru, conv_w, conv_b, gate_a_w, gate_a_b, gate_x_w, gate_x_b, lru_lambda)
    lru = rmsnorm(lru, lru_out_g) * jax.nn.silu(g_lru)
    y = jnp.concatenate([att, lru], axis=-1) @ w_out
    return h + rmsnorm(y, post_g)


def setup_inputs(seed: int = 0) -> dict:
    key = jax.random.key(seed)
    ks = jax.random.split(key, 16)
    f32 = jnp.float32
    x = jax.random.normal(ks[0], (BATCH, SEQ, D_MODEL), f32)
    meta_tokens = jax.random.normal(ks[1], (N_META, D_MODEL), f32)
    pre_g = 1.0 + 0.02 * jax.random.normal(ks[2], (DEPTH, D_MODEL), f32)
    post_g = 1.0 + 0.02 * jax.random.normal(ks[3], (DEPTH, D_MODEL), f32)
    w_in = jax.random.normal(ks[4], (DEPTH, D_MODEL, IN_WIDTH), f32) * D_MODEL ** -0.5
    w_out = jax.random.normal(ks[5], (DEPTH, MIX_WIDTH, D_MODEL), f32) * MIX_WIDTH ** -0.5
    att_out_g = 1.0 + 0.02 * jax.random.normal(ks[6], (DEPTH, ATT_WIDTH), f32)
    lru_out_g = 1.0 + 0.02 * jax.random.normal(ks[7], (DEPTH, LRU_WIDTH), f32)
    conv_w = jax.random.normal(ks[8], (DEPTH, CONV_WIDTH, LRU_WIDTH), f32) * CONV_WIDTH ** -0.5
    conv_b = 0.1 * jax.random.normal(ks[9], (DEPTH, LRU_WIDTH), f32)
    gate_a_w = jax.random.normal(ks[10], (DEPTH, LRU_BLOCKS, LRU_BLOCK_DIM, LRU_BLOCK_DIM), f32) * LRU_BLOCK_DIM ** -0.5
    gate_a_b = 0.1 * jax.random.normal(ks[11], (DEPTH, LRU_WIDTH), f32)
    gate_x_w = jax.random.normal(ks[12], (DEPTH, LRU_BLOCKS, LRU_BLOCK_DIM, LRU_BLOCK_DIM), f32) * LRU_BLOCK_DIM ** -0.5
    gate_x_b = 0.1 * jax.random.normal(ks[13], (DEPTH, LRU_WIDTH), f32)
    a_c = jax.random.uniform(ks[14], (DEPTH, LRU_WIDTH), f32, 0.9, 0.999)
    a0 = a_c ** (1.0 / LRU_C)
    lru_lambda = jnp.log(a0) - jnp.log1p(-a0)
    return {"x": x, "meta_tokens": meta_tokens, "pre_g": pre_g, "post_g": post_g,
            "w_in": w_in, "w_out": w_out, "att_out_g": att_out_g, "lru_out_g": lru_out_g,
            "conv_w": conv_w, "conv_b": conv_b, "gate_a_w": gate_a_w, "gate_a_b": gate_a_b,
            "gate_x_w": gate_x_w, "gate_x_b": gate_x_b, "lru_lambda": lru_lambda}


def reference(x, meta_tokens, pre_g, post_g, w_in, w_out, att_out_g, lru_out_g, conv_w, conv_b,
              gate_a_w, gate_a_b, gate_x_w, gate_x_b, lru_lambda):
    B = x.shape[0]
    meta = jnp.broadcast_to(meta_tokens.astype(x.dtype)[None], (B, N_META, D_MODEL))
    h = jnp.concatenate([meta, x], axis=1)
    for l in range(DEPTH):
        h = hybrid_layer(h, pre_g[l], post_g[l], w_in[l], w_out[l], att_out_g[l], lru_out_g[l],
                         conv_w[l], conv_b[l], gate_a_w[l], gate_a_b[l], gate_x_w[l], gate_x_b[l],
                         lru_lambda[l])
    return h[:, N_META:]
```

```cpp
#include <hip/hip_runtime.h>
#include <hip/hip_cooperative_groups.h>
#include <cstdio>
#include <cstdint>
namespace cg = cooperative_groups;
namespace pg8 {
#define PG8_LAS __attribute__((address_space(3)))
typedef unsigned short bf16_t;
typedef short bf16x8 __attribute__((ext_vector_type(8)));
typedef float f32x4 __attribute__((ext_vector_type(4)));
typedef unsigned u32x4 __attribute__((ext_vector_type(4)));
constexpr int BM = 256, BK = 64, HALF = 128, HTB = HALF * BK * 2  , STAGE_BYTES = 8 * HTB, NXCD = 8, WGM = 8;

__host__ __device__ __forceinline__ int lds_byte(int r, int c) { const int st = (r >> 4) * 2 + (c >> 5), rr = r & 15, cc = c & 31, ob = rr * 64 + cc * 2; return st * 1024 + (ob ^ (((ob >> 9) & 1) << 5)); }
__host__ __device__ __forceinline__ void stage_rc(int b, int& R, int& C) { const int st = b / 1024, sb = b % 1024, swz = sb ^ (((sb >> 9) & 1) << 5); R = (st >> 1) * 16 + swz / 64; C = (st & 1) * 32 + (swz % 64) / 2; }
__host__ __device__ __forceinline__ int perm32(int rho) { const int n = rho >> 4, i = rho & 15; return 8 * (i >> 2) + 4 * n + (i & 3); }

struct Unit { int pm, pn; };

struct Gemm { const bf16_t* A; const bf16_t* Bt; int M, N, K, lda, ldb; };

struct StaticOrder {
    int nM, nN, nwg, G, c;
    __host__ __device__ void init(int M, int N, int G_, int c_) { nM = M / BM; nN = N / BM; nwg = nM * nN; G = G_; c = c_; }
    __host__ __device__ bool next(int i, Unit& u) const {
        const long L = (long)i * G + c; if (L >= nwg) return false;
        int wgid = (int)L; { const int q = nwg / NXCD, r = nwg % NXCD, xcd = wgid % NXCD, off = wgid / NXCD; wgid = (xcd < r ? xcd * (q + 1) : r * (q + 1) + (xcd - r) * q) + off; }
        const int nig = WGM * nN, gid = wgid / nig, fm = gid * WGM, gsz = (nM - fm) < WGM ? (nM - fm) : WGM;
        u.pm = fm + ((wgid % nig) % gsz); u.pn = (wgid % nig) / gsz; return true;
    }
    __device__ __forceinline__ void a_ready(const Unit&) const {}
    __device__ __forceinline__ void done(const Unit&) const {}
};
typedef float f32x2_t __attribute__((ext_vector_type(2))); typedef __bf16 bf16x2_t __attribute__((ext_vector_type(2)));
__device__ __forceinline__ unsigned pk2(float lo, float hi) { f32x2_t v = {lo, hi}; bf16x2_t b = __builtin_convertvector(v, bf16x2_t); return __builtin_bit_cast(unsigned, b); }
template <class Epi, class Sched, bool ALIGN_EPI = false, bool SP2 = false>
__device__ __forceinline__ void gemm_phase(PG8_LAS unsigned char* lds, const Gemm g, const Sched& S, const Epi& E) {
    const int tid = threadIdx.x, wid = __builtin_amdgcn_readfirstlane(tid >> 6), lane = tid & 63, wr = wid >> 2, wc = wid & 3, fr = lane & 15, fq = lane >> 4;
    const int K = g.K, nt = K / BK;
    unsigned voffA[2], voffB[2];
#pragma unroll
    for (int i = 0; i < 2; ++i) { int R, C; stage_rc(tid * 16 + i * 8192, R, C); const int Rb = Epi::PERM ? ((R & ~31) + perm32(R & 31)) : R;
        voffA[i] = (unsigned)(R * g.lda + C) * 2u; voffB[i] = (unsigned)(Rb * g.ldb + C) * 2u; }
    const size_t kstep = (size_t)(BK * 2);
    const size_t hstepA = (size_t)HALF * g.lda * 2, hstepB = (size_t)HALF * g.ldb * 2;
    const size_t tstepA = 2 * hstepA, tstepB = 2 * hstepB;
    const unsigned ldsw = (unsigned)wid * 1024u;
    const int aoff = lds_byte(wr * 64 + fr, fq * 8), boff = lds_byte(wc * 32 + fr, fq * 8);
#define PG8_SA(b, h) (((b) * 2 + (h)) * HTB)
#define PG8_SB(b, h) ((4 + (b) * 2 + (h)) * HTB)
#define PG8_STAGE(bufoff, gbase, voff) do { _Pragma("unroll") for (int _i = 0; _i < 2; ++_i) \
        __builtin_amdgcn_global_load_lds((const unsigned*)((const char*)(gbase) + (voff)[_i]), (PG8_LAS unsigned*)(lds + (bufoff) + ldsw + _i * 8192), 16, 0, 0); } while (0)
#define PG8_LDA(dst, b, h) do { _Pragma("unroll") for (int m = 0; m < 4; ++m) _Pragma("unroll") for (int k = 0; k < 2; ++k) dst[m][k] = *(const PG8_LAS bf16x8*)(lds + PG8_SA(b, h) + aoff + m * 2048 + k * 1024); } while (0)
#define PG8_LDB(dst, b, h) do { _Pragma("unroll") for (int n = 0; n < 2; ++n) _Pragma("unroll") for (int k = 0; k < 2; ++k) dst[n][k] = *(const PG8_LAS bf16x8*)(lds + PG8_SB(b, h) + boff + n * 2048 + k * 1024); } while (0)
#define PG8_MMA(ai, bj, At, Bt) do { __builtin_amdgcn_s_setprio(1); _Pragma("unroll") for (int m = 0; m < 4; ++m) _Pragma("unroll") for (int n = 0; n < 2; ++n) _Pragma("unroll") for (int k = 0; k < 2; ++k) \
        acc[ai][bj][m][n] = __builtin_amdgcn_mfma_f32_16x16x32_bf16(Bt[n][k], At[m][k], acc[ai][bj][m][n], 0, 0, 0); __builtin_amdgcn_s_setprio(0); } while (0)
#define PG8_WAIT_V(n) asm volatile("s_waitcnt vmcnt(" #n ")" ::: "memory")
#define PG8_WAIT_L(n) asm volatile("s_waitcnt lgkmcnt(" #n ")" ::: "memory")
#define PG8_BAR __builtin_amdgcn_s_barrier()
#define PG8_SCHED __builtin_amdgcn_sched_barrier(0)
    Unit cur, nxt; int ui = 0;
    if (!S.next(0, cur)) return;
    f32x4 acc[2][2][4][2];
#pragma unroll
    for (int a = 0; a < 2; ++a)
#pragma unroll
        for (int b = 0; b < 2; ++b)
#pragma unroll
            for (int m = 0; m < 4; ++m)
#pragma unroll
                for (int n = 0; n < 2; ++n) acc[a][b][m][n] = (f32x4){0.f, 0.f, 0.f, 0.f};
    bf16x8 At[4][2], B0[2][2], B1[2][2];
    const char* cA = (const char*)g.A + (size_t)cur.pm * tstepA; const char* cB = (const char*)g.Bt + (size_t)cur.pn * tstepB;
    S.a_ready(cur);
    if constexpr (SP2) {
        PG8_STAGE(PG8_SB(0, 0), cB, voffB); PG8_STAGE(PG8_SB(0, 1), cB + hstepB, voffB); PG8_STAGE(PG8_SA(0, 0), cA, voffA); PG8_STAGE(PG8_SA(0, 1), cA + hstepA, voffA);
        if (wr == 1) PG8_BAR;
        PG8_WAIT_V(2); PG8_BAR;
        PG8_STAGE(PG8_SB(1, 0), cB + kstep, voffB); PG8_STAGE(PG8_SA(1, 0), cA + kstep, voffA); PG8_STAGE(PG8_SB(1, 1), cB + hstepB + kstep, voffB);
        PG8_WAIT_V(6); PG8_BAR;
    } else {
        PG8_STAGE(PG8_SB(0, 0), cB, voffB); PG8_STAGE(PG8_SA(0, 0), cA, voffA); PG8_STAGE(PG8_SB(0, 1), cB + hstepB, voffB); PG8_STAGE(PG8_SA(0, 1), cA + hstepA, voffA);
        if (wr == 1) PG8_BAR;
        PG8_WAIT_V(4); PG8_BAR;
        PG8_STAGE(PG8_SB(1, 0), cB + kstep, voffB); PG8_STAGE(PG8_SA(1, 0), cA + kstep, voffA); PG8_STAGE(PG8_SB(1, 1), cB + hstepB + kstep, voffB);
        PG8_WAIT_V(6); PG8_BAR;
    }
    for (;;) {
        const bool has_next = S.next(ui + 1, nxt);
        const char* nA = has_next ? (const char*)g.A + (size_t)nxt.pm * tstepA : cA; const char* nB = has_next ? (const char*)g.Bt + (size_t)nxt.pn * tstepB : cB;
        for (int t = 0; t < nt; t += 2) {
            const bool last = (t == nt - 2);
            const char* a1 = cA + (size_t)(t + 1) * kstep;
            const char* a2 = last ? nA : cA + (size_t)(t + 2) * kstep; const char* b2 = last ? nB : cB + (size_t)(t + 2) * kstep;
            const char* a3 = a2 + kstep; const char* b3 = b2 + kstep;
            if (last && has_next) S.a_ready(nxt);
            if constexpr (SP2) {
            PG8_LDB(B0, 0, 0); PG8_LDB(B1, 0, 1); PG8_SCHED; PG8_LDA(At, 0, 0); PG8_STAGE(PG8_SA(1, 1), a1 + hstepA, voffA);
            PG8_WAIT_V(8); PG8_WAIT_L(0); PG8_BAR; PG8_MMA(0, 0, At, B0); PG8_MMA(0, 1, At, B1); PG8_BAR; PG8_SCHED;
            PG8_LDA(At, 0, 1); PG8_STAGE(PG8_SB(0, 0), b2, voffB); PG8_STAGE(PG8_SB(0, 1), b2 + hstepB, voffB); PG8_STAGE(PG8_SA(0, 0), a2, voffA);
            PG8_WAIT_V(8); PG8_WAIT_L(0); PG8_BAR; PG8_MMA(1, 0, At, B0); PG8_MMA(1, 1, At, B1); PG8_BAR; PG8_SCHED;
            PG8_LDB(B0, 1, 0); PG8_LDB(B1, 1, 1); PG8_SCHED; PG8_LDA(At, 1, 0); PG8_STAGE(PG8_SA(0, 1), a2 + hstepA, voffA);
            PG8_WAIT_V(8); PG8_WAIT_L(0); PG8_BAR; PG8_MMA(0, 0, At, B0); PG8_MMA(0, 1, At, B1); PG8_BAR; PG8_SCHED;
            PG8_LDA(At, 1, 1); PG8_STAGE(PG8_SB(1, 0), b3, voffB); PG8_STAGE(PG8_SB(1, 1), b3 + hstepB, voffB); PG8_STAGE(PG8_SA(1, 0), a3, voffA);
            PG8_WAIT_V(8); PG8_WAIT_L(0); PG8_BAR; PG8_MMA(1, 0, At, B0); PG8_MMA(1, 1, At, B1); PG8_BAR; PG8_SCHED;
            } else {
            PG8_LDB(B0, 0, 0); PG8_SCHED; PG8_LDA(At, 0, 0); PG8_STAGE(PG8_SA(1, 1), a1 + hstepA, voffA);
            PG8_WAIT_L(8); PG8_BAR; PG8_WAIT_L(0); PG8_MMA(0, 0, At, B0); PG8_BAR; PG8_SCHED;
            PG8_LDB(B1, 0, 1); PG8_STAGE(PG8_SB(0, 0), b2, voffB);
            PG8_BAR; PG8_WAIT_L(0); PG8_MMA(0, 1, At, B1); PG8_BAR;
            PG8_LDA(At, 0, 1); PG8_STAGE(PG8_SA(0, 0), a2, voffA);
            PG8_BAR; PG8_WAIT_L(0); PG8_MMA(1, 0, At, B0); PG8_BAR; PG8_SCHED;
            PG8_STAGE(PG8_SB(0, 1), b2 + hstepB, voffB);
            PG8_WAIT_V(6); PG8_BAR; PG8_MMA(1, 1, At, B1); PG8_BAR;
            PG8_LDB(B0, 1, 0); PG8_SCHED; PG8_LDA(At, 1, 0); PG8_STAGE(PG8_SA(0, 1), a2 + hstepA, voffA);
            PG8_WAIT_L(8); PG8_BAR; PG8_WAIT_L(0); PG8_MMA(0, 0, At, B0); PG8_BAR; PG8_SCHED;
            PG8_LDB(B1, 1, 1); PG8_STAGE(PG8_SB(1, 0), b3, voffB);
            PG8_BAR; PG8_WAIT_L(0); PG8_MMA(0, 1, At, B1); PG8_BAR;
            PG8_LDA(At, 1, 1); PG8_STAGE(PG8_SA(1, 0), a3, voffA);
            PG8_BAR; PG8_WAIT_L(0); PG8_MMA(1, 0, At, B0); PG8_BAR; PG8_SCHED;
            PG8_STAGE(PG8_SB(1, 1), b3 + hstepB, voffB);
            PG8_WAIT_V(6); PG8_BAR; PG8_MMA(1, 1, At, B1); PG8_BAR;
            }
        }
        if constexpr (ALIGN_EPI) { if (wr == 0) PG8_BAR; }
        if constexpr (!Epi::AFTER_DRAIN) { E(acc, cur, wr, wc, fr, fq); S.done(cur); }
        if (!has_next) break;
#pragma unroll
        for (int a = 0; a < 2; ++a)
#pragma unroll
            for (int b = 0; b < 2; ++b)
#pragma unroll
                for (int m = 0; m < 4; ++m)
#pragma unroll
                    for (int n = 0; n < 2; ++n) acc[a][b][m][n] = (f32x4){0.f, 0.f, 0.f, 0.f};
        cur = nxt; cA = nA; cB = nB; ++ui;
        if constexpr (ALIGN_EPI) { if (wr == 1) PG8_BAR; }
    }
    PG8_WAIT_V(0);
    if constexpr (!ALIGN_EPI) { if (wr == 0) PG8_BAR; }
    PG8_BAR;
    if constexpr (Epi::AFTER_DRAIN) { E.fused(acc, cur, wr, wc, fr, fq, lds, wid, lane); S.done(cur); }
#undef PG8_SA
#undef PG8_SB
#undef PG8_STAGE
#undef PG8_LDA
#undef PG8_LDB
#undef PG8_MMA
#undef PG8_WAIT_V
#undef PG8_WAIT_L
#undef PG8_BAR
#undef PG8_SCHED
}
}


namespace mk {
using pg8::bf16_t; using pg8::bf16x8; using pg8::f32x4; using pg8::u32x4; using pg8::pk2;
#define LAS __attribute__((address_space(3)))
#define DI __device__ __forceinline__
typedef float f32x16 __attribute__((ext_vector_type(16)));
typedef unsigned u32x2 __attribute__((ext_vector_type(2)));
#define MFMA32(a, b, c) __builtin_amdgcn_mfma_f32_32x32x16_bf16((a), (b), (c), 0, 0, 0)

constexpr int D = 1024, NB = 4, SEQ = 8192;
constexpr int MX = NB * SEQ;
constexpr int M1 = MX + 256;
constexpr int MROW = MX + 16;
constexpr int LDP = 5120;
constexpr int CQ = 0, CK = 1024, CGA = 2048, CXL = 3072, CGL = 4096;
constexpr int CA_LRU = 1024;
constexpr int NCH = 65;
constexpr float EPS = 1e-6f;
constexpr size_t Z_W_BYTES = (size_t)6144 * 1024 * 2, Z_U_BYTES = (size_t)M1 * 1024 * 2, VT_BYTES = (size_t)1024 * M1 * 2;
constexpr size_t OFF_Z = 0;
constexpr size_t OFF_VT = OFF_Z + Z_W_BYTES + Z_U_BYTES;
constexpr size_t OFF_Y = OFF_Z + Z_W_BYTES;
constexpr size_t OFF_P = OFF_VT + VT_BYTES;
constexpr size_t OFF_W2 = OFF_P + (size_t)M1 * LDP * 2;
constexpr size_t OFF_GT = OFF_W2 + (size_t)1024 * 2048 * 2;
constexpr size_t OFF_TOT = OFF_GT + (size_t)2 * 16 * 64 * 64 * 2;
constexpr size_t WS_END = OFF_TOT + (size_t)NB * NCH * 2 * 1024 * 4;
static_assert((size_t)MX * 1024 * 4 <= Z_U_BYTES + VT_BYTES, "Y overlay");
constexpr int LDS_BYTES = 147456;

struct Args { const float *x, *meta, *pre_g, *post_g, *w_in, *w_out, *att_g, *lru_g, *conv_w, *conv_b, *gaw, *gab, *gxw, *gxb, *lam; float* out; unsigned char* ws; };

DI float wave_sum(float v) {
#pragma unroll
    for (int o = 1; o < 64; o <<= 1) v += __shfl_xor(v, o);
    return v;
}
DI float bflo(unsigned u) { return __uint_as_float(u << 16); }
DI float bfhi(unsigned u) { return __uint_as_float(u & 0xffff0000u); }
DI int crow(int r, int hh) { return (r & 3) + 8 * (r >> 2) + 4 * hh; }
#define LDS_WAIT() asm volatile("s_waitcnt lgkmcnt(0)" ::: "memory")

DI void p0_transpose_item(const float* W, int K, int N, bf16_t* WT, int ldw, int drow0, LAS float* scr, int kb, int nb, int lane) {
    const int k0 = 64 * kb, n0 = 32 * nb;
#pragma unroll 8
    for (int i = 0; i < 32; ++i) { const int kk = 2 * i + (lane >> 5); scr[kk * 33 + (lane & 31)] = W[(size_t)(k0 + kk) * N + n0 + (lane & 31)]; }
    LDS_WAIT();
    const int c = lane & 7;
#pragma unroll
    for (int j = 0; j < 4; ++j) { const int n = (lane >> 3) + 8 * j; const LAS float* s = scr + (8 * c) * 33 + n;
        u32x4 o; o.x = pk2(s[0 * 33], s[1 * 33]); o.y = pk2(s[2 * 33], s[3 * 33]); o.z = pk2(s[4 * 33], s[5 * 33]); o.w = pk2(s[6 * 33], s[7 * 33]);
        *(u32x4*)(WT + (size_t)(drow0 + n) * ldw + k0 + 8 * c) = o; }
    LDS_WAIT();
}
DI void p0_prep(const Args& a, LAS unsigned char* lds, int G, int bid, int wave, int lane) {
    unsigned char* ws = a.ws;
    bf16_t* Z = (bf16_t*)(ws + OFF_Z); bf16_t* W2t = (bf16_t*)(ws + OFF_W2); bf16_t* GT = (bf16_t*)(ws + OFF_GT);
    LAS float* scr = (LAS float*)(lds + wave * 16384);
    const int gw = bid * 8 + wave, NGW = G * 8;
    for (int it = gw; it < 16 * 192; it += NGW) {
        const int kb = it / 192, nb = it % 192, n0 = 32 * nb, seg = n0 >> 10;
        const int dseg = seg == 0 ? 0 : seg == 1 ? 1 : seg == 2 ? 5 : seg - 1;
        p0_transpose_item(a.w_in, 1024, 6144, Z, 1024, dseg * 1024 + (n0 & 1023), scr, kb, nb, lane);
    }
    for (int it = gw; it < 32 * 32; it += NGW) { const int kb = it / 32, nb = it % 32; p0_transpose_item(a.w_out, 2048, 1024, W2t, 2048, 32 * nb, scr, kb, nb, lane); }
    bf16_t* U = Z + (size_t)6144 * 1024;
    f32x4 gv[4];
#pragma unroll
    for (int j = 0; j < 4; ++j) gv[j] = ((const f32x4*)a.pre_g)[64 * j + lane];
    for (int m = gw; m < M1; m += NGW) {
        unsigned long long* o8 = (unsigned long long*)(U + (size_t)m * 1024) + lane;
        const float* src = (m < MX) ? a.x + (size_t)m * 1024 : ((m >= MROW && m < MROW + 16) ? a.meta + (size_t)(m - MROW) * 1024 : nullptr);
        if (src == nullptr) {
#pragma unroll
            for (int j = 0; j < 4; ++j) o8[64 * j] = 0ull;
            continue; }
        const f32x4* xr = (const f32x4*)src + lane;
        f32x4 v[4]; float s = 0.f;
#pragma unroll
        for (int j = 0; j < 4; ++j) { v[j] = xr[64 * j]; s += (v[j].x * v[j].x + v[j].y * v[j].y) + (v[j].z * v[j].z + v[j].w * v[j].w); }
        const float rstd = rsqrtf(wave_sum(s) * (1.f / 1024.f) + EPS);
#pragma unroll
        for (int j = 0; j < 4; ++j) { const f32x4 t = v[j] * rstd * gv[j]; o8[64 * j] = (unsigned long long)pk2(t.x, t.y) | ((unsigned long long)pk2(t.z, t.w) << 32); }
    }
    for (int idx = bid * 512 + wave * 64 + lane; idx < 2 * 16 * 64 * 64; idx += G * 512) {
        const int i = idx & 63, j = (idx >> 6) & 63, n = (idx >> 12) & 15, gate = idx >> 16;
        const float* src = gate ? a.gxw : a.gaw;
        GT[idx] = (bf16_t)(pk2(src[(n * 64 + i) * 64 + j], 0.f) & 0xffffu);
    }
}

struct Sched1 {
    int G, c;
    DI bool next(int i, pg8::Unit& u) const {
        const long L = (long)i * G + c; if (L >= 3096) return false;
        if (L < 2580) {
            constexpr int nM = 129, nN = 20, nwg = 2580;
            int wgid = (int)L; { const int q = nwg / 8, r = nwg % 8, xcd = wgid % 8, off = wgid / 8; wgid = (xcd < r ? xcd * (q + 1) : r * (q + 1) + (xcd - r) * q) + off; }
            const int nig = 8 * nN, gid = wgid / nig, fm = gid * 8, gsz = (nM - fm) < 8 ? (nM - fm) : 8;
            u.pm = 24 + fm + ((wgid % nig) % gsz); u.pn = (wgid % nig) / gsz;
        } else { const int l = (int)L - 2580; u.pm = 20 + l / 129; u.pn = 24 + l % 129; }
        return true;
    }
    DI void a_ready(const pg8::Unit&) const {}
    DI void done(const pg8::Unit&) const {}
};
DI float silu(float v) { return v * __builtin_amdgcn_rcpf(1.f + __expf(-v)); }
struct EpiP {
    static constexpr bool PERM = true, AFTER_DRAIN = false;
    bf16_t* P; bf16_t* VT;
    DI void operator()(const f32x4 (&acc)[2][2][4][2], const pg8::Unit& u, int wr, int wc, int fr, int fq) const {
        bf16_t* base; size_t ldc; int row0, col0, seg;
        if (u.pm >= 24) { base = P; ldc = LDP; row0 = (u.pm - 24) * 256 + wr * 64 + fr; col0 = u.pn * 256 + wc * 32 + 8 * fq; seg = u.pn >> 2; }
        else { base = VT; ldc = M1; row0 = (u.pm - 20) * 256 + wr * 64 + fr; col0 = (u.pn - 24) * 256 + wc * 32 + 8 * fq; seg = 1; }
        const float sc = (seg == 0) ? 0.08838834764831845f : 1.f;
        const bool act = (seg == 2 || seg == 4);
#pragma unroll
        for (int ai = 0; ai < 2; ++ai)
#pragma unroll
            for (int m = 0; m < 4; ++m) { bf16_t* rowp = base + (size_t)(row0 + ai * 128 + m * 16) * ldc + col0;
#pragma unroll
                for (int bj = 0; bj < 2; ++bj) { f32x4 v0 = acc[ai][bj][m][0] * sc, v1 = acc[ai][bj][m][1] * sc;
                    if (act) { v0 = (f32x4){silu(v0[0]), silu(v0[1]), silu(v0[2]), silu(v0[3])}; v1 = (f32x4){silu(v1[0]), silu(v1[1]), silu(v1[2]), silu(v1[3])}; }
                    u32x4 w; w.x = pk2(v0[0], v0[1]); w.y = pk2(v0[2], v0[3]); w.z = pk2(v1[0], v1[1]); w.w = pk2(v1[2], v1[3]);
                    *(u32x4*)(rowp + bj * 128) = w; } }
    }
};
struct EpiY {
    static constexpr bool PERM = false, AFTER_DRAIN = false;
    float* Y;
    DI void operator()(const f32x4 (&acc)[2][2][4][2], const pg8::Unit& u, int wr, int wc, int fr, int fq) const {
        const int col0 = u.pn * 256 + wc * 32 + 4 * fq;
#pragma unroll
        for (int ai = 0; ai < 2; ++ai)
#pragma unroll
            for (int m = 0; m < 4; ++m) { float* rowp = Y + (size_t)(u.pm * 256 + ai * 128 + wr * 64 + m * 16 + fr) * 1024 + col0;
#pragma unroll
                for (int bj = 0; bj < 2; ++bj)
#pragma unroll
                    for (int n = 0; n < 2; ++n) *(f32x4*)(rowp + bj * 128 + n * 16) = acc[ai][bj][m][n]; }
    }
};
DI void attn_unit(LAS unsigned char* lds, bf16_t* P, const bf16_t* VT, const float* attg, int b, int qt, int wave, int lane, int par) {
    const int h = wave, ql = lane & 31, hh = lane >> 5;
    const int m0 = b * SEQ + qt * 32;
    const bf16_t* qp = P + (size_t)(m0 + ql) * LDP + CQ + h * 128 + hh * 64;
    bf16x8 qf[8];
#pragma unroll
    for (int s = 0; s < 8; ++s) qf[s] = *(const bf16x8*)(qp + s * 8);
    f32x16 O[4];
#pragma unroll
    for (int dt = 0; dt < 4; ++dt)
#pragma unroll
        for (int r = 0; r < 16; ++r) O[dt][r] = 0.f;
    unsigned dmask = 0u;
#pragma unroll
    for (int r = 0; r < 16; ++r) dmask |= (crow(r, hh) < ql) ? (1u << r) : 0u;
    float carry = 1.f;
    for (int kt = qt; kt >= -1; --kt) {
        const int krow0 = (kt >= 0) ? b * SEQ + kt * 32 : MX;
        const bf16_t* kp = P + (size_t)(krow0 + ql) * LDP + CK + h * 128 + hh * 64;
        bf16x8 kf[8];
#pragma unroll
        for (int s = 0; s < 8; ++s) kf[s] = *(const bf16x8*)(kp + s * 8);
        const bf16_t* vp = VT + (size_t)(h * 128 + ql) * M1 + krow0 + 4 * hh;
        bf16x8 vf[4][2];
#pragma unroll
        for (int dt = 0; dt < 4; ++dt)
#pragma unroll
            for (int s2 = 0; s2 < 2; ++s2) {
                const u32x2 lo = *(const u32x2*)(vp + (size_t)dt * 32 * M1 + 16 * s2), hi = *(const u32x2*)(vp + (size_t)dt * 32 * M1 + 16 * s2 + 8);
                u32x4 t; t.x = lo.x; t.y = lo.y; t.z = hi.x; t.w = hi.y; vf[dt][s2] = __builtin_bit_cast(bf16x8, t); }
        f32x16 S;
#pragma unroll
        for (int r = 0; r < 16; ++r) S[r] = 0.f;
#pragma unroll
        for (int s = 0; s < 8; ++s) S = MFMA32(kf[s], qf[s], S);
        const unsigned vm = (kt == qt) ? dmask : (kt < 0 ? 0xff00u : 0xffffu);
        float om[16], be[16];
#pragma unroll
        for (int r = 0; r < 16; ++r) {
            const float z = fminf(S[r], 80.f), e = __expf(z), rc = __builtin_amdgcn_rcpf(1.f + e);
            const bool v = (vm >> r) & 1u;
            om[r] = v ? rc : 1.f; be[r] = v ? e * rc : 0.f; }
        float G4[4], PG[4], T[4];
#pragma unroll
        for (int g = 0; g < 4; ++g) G4[g] = (om[4 * g] * om[4 * g + 1]) * (om[4 * g + 2] * om[4 * g + 3]);
#pragma unroll
        for (int g = 0; g < 4; ++g) PG[g] = __shfl_xor(G4[g], 32);
        T[3] = carry; T[2] = T[3] * (G4[3] * PG[3]); T[1] = T[2] * (G4[2] * PG[2]); T[0] = T[1] * (G4[1] * PG[1]);
        carry = T[0] * (G4[0] * PG[0]);
        float w[16];
#pragma unroll
        for (int g = 0; g < 4; ++g) {
            float sf = hh ? T[g] : T[g] * PG[g];
            w[4 * g + 3] = be[4 * g + 3] * sf; sf *= om[4 * g + 3];
            w[4 * g + 2] = be[4 * g + 2] * sf; sf *= om[4 * g + 2];
            w[4 * g + 1] = be[4 * g + 1] * sf; sf *= om[4 * g + 1];
            w[4 * g + 0] = be[4 * g + 0] * sf; }
        bf16x8 wf[2];
#pragma unroll
        for (int s2 = 0; s2 < 2; ++s2) { u32x4 t; t.x = pk2(w[8 * s2], w[8 * s2 + 1]); t.y = pk2(w[8 * s2 + 2], w[8 * s2 + 3]); t.z = pk2(w[8 * s2 + 4], w[8 * s2 + 5]); t.w = pk2(w[8 * s2 + 6], w[8 * s2 + 7]);
            wf[s2] = __builtin_bit_cast(bf16x8, t); }
#pragma unroll
        for (int dt = 0; dt < 4; ++dt)
#pragma unroll
            for (int s2 = 0; s2 < 2; ++s2) O[dt] = MFMA32(vf[dt][s2], wf[s2], O[dt]);
        if (__ballot(carry >= 1e-38f) == 0ull) break;
    }
    float ssq = 0.f;
#pragma unroll
    for (int dt = 0; dt < 4; ++dt)
#pragma unroll
        for (int r = 0; r < 16; ++r) ssq += O[dt][r] * O[dt][r];
    ssq += __shfl_xor(ssq, 32);
    LAS float* red = (LAS float*)lds + par * 256;
    if (hh == 0) red[wave * 32 + ql] = ssq;
    __syncthreads();
    float tot = 0.f;
#pragma unroll
    for (int w8 = 0; w8 < 8; ++w8) tot += red[w8 * 32 + ql];
    const float rstd = rsqrtf(tot * (1.f / 1024.f) + EPS);
    bf16_t* orow = P + (size_t)(m0 + ql) * LDP;
#pragma unroll
    for (int dt = 0; dt < 4; ++dt)
#pragma unroll
        for (int g = 0; g < 4; ++g) {
            const int c = h * 128 + dt * 32 + 8 * g + 4 * hh;
            const f32x4 gg = *(const f32x4*)(attg + c);
            const u32x2 sg = *(const u32x2*)(orow + CGA + c);
            u32x2 o;
            o.x = pk2(O[dt][4 * g] * rstd * gg.x * bflo(sg.x), O[dt][4 * g + 1] * rstd * gg.y * bfhi(sg.x));
            o.y = pk2(O[dt][4 * g + 2] * rstd * gg.z * bflo(sg.y), O[dt][4 * g + 3] * rstd * gg.w * bfhi(sg.y));
            *(u32x2*)(orow + CQ + c) = o; }
}

template <int PASS>
DI void lru_unit(LAS unsigned char* lds, bf16_t* P, const bf16_t* GT, const Args& a, float* TOT, int b, int c, int wave, int lane) {
    const int ql = lane & 31, hh = lane >> 5, chq = lane & 7, tq = lane >> 3;
    LAS float* xcs = (LAS float*)(lds + 4096 + wave * 8704);
    const int ntiles = (c == 0) ? 1 : 4;
#pragma unroll 1
    for (int nbk = 0; nbk < 2; ++nbk) {
        const int n = 2 * wave + nbk, cc0 = n * 64 + 8 * chq;
        float cwr[4][8], cbr[8];
#pragma unroll
        for (int jj = 0; jj < 4; ++jj) { const f32x4 t0 = *(const f32x4*)(a.conv_w + jj * 1024 + cc0), t1 = *(const f32x4*)(a.conv_w + jj * 1024 + cc0 + 4);
            cwr[jj][0] = t0.x; cwr[jj][1] = t0.y; cwr[jj][2] = t0.z; cwr[jj][3] = t0.w; cwr[jj][4] = t1.x; cwr[jj][5] = t1.y; cwr[jj][6] = t1.z; cwr[jj][7] = t1.w; }
        { const f32x4 t0 = *(const f32x4*)(a.conv_b + cc0), t1 = *(const f32x4*)(a.conv_b + cc0 + 4);
            cbr[0] = t0.x; cbr[1] = t0.y; cbr[2] = t0.z; cbr[3] = t0.w; cbr[4] = t1.x; cbr[5] = t1.y; cbr[6] = t1.z; cbr[7] = t1.w; }
        float gabv[2], gxbv[2], lsl8[2], st[2], At[2];
#pragma unroll
        for (int nt = 0; nt < 2; ++nt) { const int ch = n * 64 + nt * 32 + ql; gabv[nt] = a.gab[ch]; gxbv[nt] = a.gxb[ch];
            const float l = a.lam[ch]; lsl8[nt] = 8.f * (fminf(l, 0.f) - log1pf(__expf(-fabsf(l))));
            st[nt] = 0.f; At[nt] = 1.f;
            if (PASS == 2) { float s = 0.f; const float* tp = TOT + (size_t)(b * NCH) * 2048 + ch;
                for (int cc = 0; cc < c; ++cc) { const float A_ = tp[(size_t)cc * 2048], H_ = tp[(size_t)cc * 2048 + 1024]; s = A_ * s + H_; }
                st[nt] = s; } }
#pragma unroll 1
        for (int ti = 0; ti < ntiles; ++ti) {
            const int tpos0 = (c == 0) ? -32 : (c - 1) * 128 + ti * 32;
            u32x4 xr[7];
#pragma unroll
            for (int k = 0; k < 7; ++k) { const int tp = tpos0 + 4 * tq - 3 + k; const int row = tp >= 0 ? b * SEQ + tp : (tp >= -32 ? MX + 32 + tp : MX);
                xr[k] = *(const u32x4*)(P + (size_t)row * LDP + CXL + cc0); }
#pragma unroll
            for (int i = 0; i < 4; ++i) { float xc[8];
#pragma unroll
                for (int e = 0; e < 8; ++e) { float acc = cbr[e];
#pragma unroll
                    for (int jj = 0; jj < 4; ++jj) { const unsigned uw = xr[i + jj][e >> 1]; acc += ((e & 1) ? bfhi(uw) : bflo(uw)) * cwr[jj][e]; }
                    xc[e] = acc; }
                LAS float* dst = xcs + (4 * tq + i) * 68 + 8 * chq;
                *(LAS f32x4*)dst = (f32x4){xc[0], xc[1], xc[2], xc[3]}; *(LAS f32x4*)(dst + 4) = (f32x4){xc[4], xc[5], xc[6], xc[7]}; }
            LDS_WAIT();
            bf16x8 af[4];
#pragma unroll
            for (int s = 0; s < 4; ++s) { const f32x4 v0 = *(const LAS f32x4*)(xcs + ql * 68 + 16 * s + 8 * hh), v1 = *(const LAS f32x4*)(xcs + ql * 68 + 16 * s + 8 * hh + 4);
                u32x4 t; t.x = pk2(v0.x, v0.y); t.y = pk2(v0.z, v0.w); t.z = pk2(v1.x, v1.y); t.w = pk2(v1.z, v1.w); af[s] = __builtin_bit_cast(bf16x8, t); }
#pragma unroll
            for (int nt = 0; nt < 2; ++nt) {
                f32x16 ga, gx;
#pragma unroll
                for (int r = 0; r < 16; ++r) { ga[r] = 0.f; gx[r] = 0.f; }
#pragma unroll
                for (int s = 0; s < 4; ++s) {
                    const bf16x8 ba = *(const bf16x8*)(GT + ((size_t)((0 * 16 + n) * 64 + nt * 32 + ql)) * 64 + 16 * s + 8 * hh);
                    const bf16x8 bx = *(const bf16x8*)(GT + ((size_t)((1 * 16 + n) * 64 + nt * 32 + ql)) * 64 + 16 * s + 8 * hh);
                    ga = MFMA32(af[s], ba, ga); gx = MFMA32(af[s], bx, gx); }
                float av[16], bv[16];
#pragma unroll
                for (int r = 0; r < 16; ++r) {
                    const int tok = crow(r, hh);
                    const float ra = __builtin_amdgcn_rcpf(1.f + __expf(-(ga[r] + gabv[nt]))), ix = __builtin_amdgcn_rcpf(1.f + __expf(-(gx[r] + gxbv[nt])));
                    const float la = ra * lsl8[nt], x2 = 2.f * la;
                    float av_ = __expf(la);
                    const float m2 = (x2 > -0.2f) ? -x2 * (1.f + x2 * (0.5f + x2 * (0.16666667f + x2 * (0.041666668f + x2 * (0.0083333338f + x2 * 0.0013888889f))))) : 1.f - __expf(x2);
                    float bv_ = sqrtf(m2) * ix * xcs[tok * 68 + nt * 32 + ql];
                    if (c == 0 && tok < 16) { av_ = 1.f; bv_ = 0.f; }
                    av[r] = av_; bv[r] = bv_; }
                float Ag[4], Bg[4], PA[4], PB[4];
#pragma unroll
                for (int g = 0; g < 4; ++g) { float A_ = 1.f, B_ = 0.f;
#pragma unroll
                    for (int i = 0; i < 4; ++i) { B_ = av[4 * g + i] * B_ + bv[4 * g + i]; A_ *= av[4 * g + i]; }
                    Ag[g] = A_; Bg[g] = B_; }
#pragma unroll
                for (int g = 0; g < 4; ++g) { PA[g] = __shfl_xor(Ag[g], 32); PB[g] = __shfl_xor(Bg[g], 32); }
                float s = st[nt], atot = At[nt], start[4];
#pragma unroll
                for (int g = 0; g < 4; ++g) {
                    const float A0 = hh ? PA[g] : Ag[g], B0 = hh ? PB[g] : Bg[g], A1 = hh ? Ag[g] : PA[g], B1 = hh ? Bg[g] : PB[g];
                    const float s0 = s; s = A0 * s + B0; const float s1 = s; s = A1 * s + B1;
                    start[g] = hh ? s1 : s0; atot *= A0 * A1; }
                st[nt] = s; At[nt] = atot;
                if (PASS == 2) {
                    const int ch = n * 64 + nt * 32 + ql;
#pragma unroll
                    for (int g = 0; g < 4; ++g) { float hc = start[g];
#pragma unroll
                        for (int i = 0; i < 4; ++i) { hc = av[4 * g + i] * hc + bv[4 * g + i];
                            P[(size_t)(b * SEQ + tpos0 + 8 * g + 4 * hh + i) * LDP + CA_LRU + ch] = (bf16_t)(pk2(hc, 0.f) & 0xffffu); } }
                }
            }
            LDS_WAIT();
        }
        if (PASS == 1 && hh == 0) {
#pragma unroll
            for (int nt = 0; nt < 2; ++nt) { const int ch = n * 64 + nt * 32 + ql; float* tp = TOT + (size_t)(b * NCH + c) * 2048 + ch; tp[0] = At[nt]; tp[1024] = st[nt]; }
        }
    }
    if (PASS == 2) {
        __threadfence(); __syncthreads(); __builtin_amdgcn_fence(__ATOMIC_ACQUIRE, "agent");
#pragma unroll 1
        for (int rr = 0; rr < 16; ++rr) {
            const int row = b * SEQ + (c - 1) * 128 + wave * 16 + rr;
            bf16_t* hp = P + (size_t)row * LDP + CA_LRU + 16 * lane; const bf16_t* gp = P + (size_t)row * LDP + CGL + 16 * lane;
            const u32x4 h0 = *(const u32x4*)hp, h1 = *(const u32x4*)(hp + 8), s0 = *(const u32x4*)gp, s1 = *(const u32x4*)(gp + 8);
            float hv[16], sv[16];
#pragma unroll
            for (int e = 0; e < 4; ++e) { hv[2 * e] = bflo(h0[e]); hv[2 * e + 1] = bfhi(h0[e]); hv[8 + 2 * e] = bflo(h1[e]); hv[8 + 2 * e + 1] = bfhi(h1[e]);
                sv[2 * e] = bflo(s0[e]); sv[2 * e + 1] = bfhi(s0[e]); sv[8 + 2 * e] = bflo(s1[e]); sv[8 + 2 * e + 1] = bfhi(s1[e]); }
            float ss = 0.f;
#pragma unroll
            for (int e = 0; e < 16; ++e) ss += hv[e] * hv[e];
            const float rstd = rsqrtf(wave_sum(ss) * (1.f / 1024.f) + EPS);
            float ov[16];
#pragma unroll
            for (int e4 = 0; e4 < 4; ++e4) { const f32x4 gg = *(const f32x4*)(a.lru_g + 16 * lane + 4 * e4);
                ov[4 * e4] = hv[4 * e4] * rstd * gg.x * sv[4 * e4]; ov[4 * e4 + 1] = hv[4 * e4 + 1] * rstd * gg.y * sv[4 * e4 + 1];
                ov[4 * e4 + 2] = hv[4 * e4 + 2] * rstd * gg.z * sv[4 * e4 + 2]; ov[4 * e4 + 3] = hv[4 * e4 + 3] * rstd * gg.w * sv[4 * e4 + 3]; }
            u32x4 o0, o1;
#pragma unroll
            for (int e = 0; e < 4; ++e) { o0[e] = pk2(ov[2 * e], ov[2 * e + 1]); o1[e] = pk2(ov[8 + 2 * e], ov[8 + 2 * e + 1]); }
            *(u32x4*)hp = o0; *(u32x4*)(hp + 8) = o1;
        }
    }
}

DI void p5_final(const Args& a, const float* Y, int G, int bid, int wave, int lane) {
    f32x4 gv[4];
#pragma unroll
    for (int j = 0; j < 4; ++j) gv[j] = ((const f32x4*)a.post_g)[64 * j + lane];
    for (int m = bid * 8 + wave; m < MX; m += G * 8) {
        const f32x4* yr = (const f32x4*)(Y + (size_t)m * 1024) + lane; const f32x4* xr = (const f32x4*)(a.x + (size_t)m * 1024) + lane; f32x4* orow = (f32x4*)(a.out + (size_t)m * 1024) + lane;
        f32x4 v[4], xv[4]; float s = 0.f;
#pragma unroll
        for (int j = 0; j < 4; ++j) { v[j] = yr[64 * j]; xv[j] = xr[64 * j]; s += (v[j].x * v[j].x + v[j].y * v[j].y) + (v[j].z * v[j].z + v[j].w * v[j].w); }
        const float rstd = rsqrtf(wave_sum(s) * (1.f / 1024.f) + EPS);
#pragma unroll
        for (int j = 0; j < 4; ++j) orow[64 * j] = xv[j] + v[j] * rstd * gv[j];
    }
}

__global__ void __launch_bounds__(512, 2) hymba_fwd(Args a) {
    extern __shared__ __attribute__((aligned(16))) unsigned char lds_raw[];
    LAS unsigned char* lds = (LAS unsigned char*)lds_raw;
    cg::grid_group grid = cg::this_grid();
    const int tid = threadIdx.x, lane = tid & 63, wave = __builtin_amdgcn_readfirstlane(tid >> 6), G = gridDim.x, bid = blockIdx.x;
    unsigned char* ws = a.ws;
    bf16_t* Z = (bf16_t*)(ws + OFF_Z); bf16_t* VT = (bf16_t*)(ws + OFF_VT); bf16_t* P = (bf16_t*)(ws + OFF_P); bf16_t* W2t = (bf16_t*)(ws + OFF_W2);
    bf16_t* GT = (bf16_t*)(ws + OFF_GT); float* TOT = (float*)(ws + OFF_TOT); float* Y = (float*)(ws + OFF_Y);

    p0_prep(a, lds, G, bid, wave, lane);
    grid.sync();
    {
        pg8::Gemm g{Z, Z, 0, 0, 1024, 1024, 1024}; Sched1 S{G, bid}; EpiP E{P, VT};
        pg8::gemm_phase<EpiP, Sched1, true, true>(lds, g, S, E);
    }
    grid.sync();
    {
        for (int u = bid; u < NB * 64; u += G) lru_unit<1>(lds, P, GT, a, TOT, u >> 6, u & 63, wave, lane);
        __syncthreads();
        int par = 0;
        for (int u = bid; u < NB * 256; u += G, par ^= 1) attn_unit(lds, P, VT, a.att_g, u >> 8, u & 255, wave, lane, par);
    }
    grid.sync();
    {
        for (int u = bid; u < NB * 64; u += G) { lru_unit<2>(lds, P, GT, a, TOT, u >> 6, 1 + (u & 63), wave, lane); __syncthreads(); }
    }
    grid.sync();
    {
        pg8::Gemm g{P, W2t, MX, 1024, 2048, LDP, 2048}; pg8::StaticOrder S; S.init(MX, 1024, G, bid); EpiY E{Y};
        pg8::gemm_phase<EpiY, pg8::StaticOrder, true, true>(lds, g, S, E);
    }
    grid.sync();
    p5_final(a, Y, G, bid, wave, lane);
}
}

extern "C" void kernel_launch(void* const* d_in, const int* in_sizes, int n_in, void* d_out, int out_size, void* d_ws, size_t ws_size, hipStream_t stream) {
    static int grid = 0;
    if (grid == 0) {
        if (n_in != 15 || out_size != mk::MX * 1024 || ws_size < mk::WS_END) { fprintf(stderr, "kernel_launch: unexpected shapes (n_in %d, out %d, ws %zu, need %zu)\n", n_in, out_size, ws_size, (size_t)mk::WS_END); grid = -1; return; }
        int dev = 0, cus = 0, per_cu = 0;
        (void)hipGetDevice(&dev); (void)hipDeviceGetAttribute(&cus, hipDeviceAttributeMultiprocessorCount, dev);
        if (hipFuncSetAttribute((const void*)mk::hymba_fwd, hipFuncAttributeMaxDynamicSharedMemorySize, mk::LDS_BYTES) != hipSuccess) { fprintf(stderr, "kernel_launch: hipFuncSetAttribute failed\n"); grid = -1; return; }
        if (hipOccupancyMaxActiveBlocksPerMultiprocessor(&per_cu, (const void*)mk::hymba_fwd, 512, mk::LDS_BYTES) != hipSuccess || per_cu < 1) { fprintf(stderr, "kernel_launch: occupancy query says %d\n", per_cu); per_cu = 1; }
        (void)hipGetLastError();
        grid = cus;
    }
    if (grid < 0) return;
    mk::Args a{};
    a.x = (const float*)d_in[0]; a.meta = (const float*)d_in[1]; a.pre_g = (const float*)d_in[2]; a.post_g = (const float*)d_in[3]; a.w_in = (const float*)d_in[4]; a.w_out = (const float*)d_in[5];
    a.att_g = (const float*)d_in[6]; a.lru_g = (const float*)d_in[7]; a.conv_w = (const float*)d_in[8]; a.conv_b = (const float*)d_in[9]; a.gaw = (const float*)d_in[10]; a.gab = (const float*)d_in[11];
    a.gxw = (const float*)d_in[12]; a.gxb = (const float*)d_in[13]; a.lam = (const float*)d_in[14]; a.out = (float*)d_out; a.ws = (unsigned char*)d_ws;
    void* args[] = {&a};
    hipError_t e = hipLaunchCooperativeKernel((const void*)mk::hymba_fwd, dim3(grid), dim3(512), args, mk::LDS_BYTES, stream);
    if (e != hipSuccess) fprintf(stderr, "kernel_launch: cooperative launch failed: %s (grid %d)\n", hipGetErrorString(e), grid);
}
```

```cpp
#include <hip/hip_runtime.h>
#include <hip/hip_cooperative_groups.h>
#include <cstdio>
#include <cstdint>
namespace cg = cooperative_groups;
namespace pg8 {
#define PG8_LAS __attribute__((address_space(3)))
typedef unsigned short bf16_t;
typedef short bf16x8 __attribute__((ext_vector_type(8)));
typedef float f32x4 __attribute__((ext_vector_type(4)));
typedef unsigned u32x4 __attribute__((ext_vector_type(4)));
constexpr int BM = 256, BK = 64, HALF = 128, HTB = HALF * BK * 2  , STAGE_BYTES = 8 * HTB, NXCD = 8, WGM = 8;

__host__ __device__ __forceinline__ int lds_byte(int r, int c) { const int st = (r >> 4) * 2 + (c >> 5), rr = r & 15, cc = c & 31, ob = rr * 64 + cc * 2; return st * 1024 + (ob ^ (((ob >> 9) & 1) << 5)); }
__host__ __device__ __forceinline__ void stage_rc(int b, int& R, int& C) { const int st = b / 1024, sb = b % 1024, swz = sb ^ (((sb >> 9) & 1) << 5); R = (st >> 1) * 16 + swz / 64; C = (st & 1) * 32 + (swz % 64) / 2; }
__host__ __device__ __forceinline__ int perm32(int rho) { const int n = rho >> 4, i = rho & 15; return 8 * (i >> 2) + 4 * n + (i & 3); }

struct Unit { int pm, pn; };

struct Gemm { const bf16_t* A; const bf16_t* Bt; int M, N, K, lda, ldb; };

struct StaticOrder {
    int nM, nN, nwg, G, c;
    __host__ __device__ void init(int M, int N, int G_, int c_) { nM = M / BM; nN = N / BM; nwg = nM * nN; G = G_; c = c_; }
    __host__ __device__ bool next(int i, Unit& u) const {
        const long L = (long)i * G + c; if (L >= nwg) return false;
        int wgid = (int)L; { const int q = nwg / NXCD, r = nwg % NXCD, xcd = wgid % NXCD, off = wgid / NXCD; wgid = (xcd < r ? xcd * (q + 1) : r * (q + 1) + (xcd - r) * q) + off; }
        const int nig = WGM * nN, gid = wgid / nig, fm = gid * WGM, gsz = (nM - fm) < WGM ? (nM - fm) : WGM;
        u.pm = fm + ((wgid % nig) % gsz); u.pn = (wgid % nig) / gsz; return true;
    }
    __device__ __forceinline__ void a_ready(const Unit&) const {}
    __device__ __forceinline__ void done(const Unit&) const {}
};
typedef float f32x2_t __attribute__((ext_vector_type(2))); typedef __bf16 bf16x2_t __attribute__((ext_vector_type(2)));
__device__ __forceinline__ unsigned pk2(float lo, float hi) { f32x2_t v = {lo, hi}; bf16x2_t b = __builtin_convertvector(v, bf16x2_t); return __builtin_bit_cast(unsigned, b); }
template <class Epi, class Sched, bool ALIGN_EPI = false, bool SP2 = false>
__device__ __forceinline__ void gemm_phase(PG8_LAS unsigned char* lds, const Gemm g, const Sched& S, const Epi& E) {
    const int tid = threadIdx.x, wid = __builtin_amdgcn_readfirstlane(tid >> 6), lane = tid & 63, wr = wid >> 2, wc = wid & 3, fr = lane & 15, fq = lane >> 4;
    const int K = g.K, nt = K / BK;
    unsigned voffA[2], voffB[2];
#pragma unroll
    for (int i = 0; i < 2; ++i) { int R, C; stage_rc(tid * 16 + i * 8192, R, C); const int Rb = Epi::PERM ? ((R & ~31) + perm32(R & 31)) : R;
        voffA[i] = (unsigned)(R * g.lda + C) * 2u; voffB[i] = (unsigned)(Rb * g.ldb + C) * 2u; }
    const size_t kstep = (size_t)(BK * 2);
    const size_t hstepA = (size_t)HALF * g.lda * 2, hstepB = (size_t)HALF * g.ldb * 2;
    const size_t tstepA = 2 * hstepA, tstepB = 2 * hstepB;
    const unsigned ldsw = (unsigned)wid * 1024u;
    const int aoff = lds_byte(wr * 64 + fr, fq * 8), boff = lds_byte(wc * 32 + fr, fq * 8);
#define PG8_SA(b, h) (((b) * 2 + (h)) * HTB)
#define PG8_SB(b, h) ((4 + (b) * 2 + (h)) * HTB)
#define PG8_STAGE(bufoff, gbase, voff) do { _Pragma("unroll") for (int _i = 0; _i < 2; ++_i) \
        __builtin_amdgcn_global_load_lds((const unsigned*)((const char*)(gbase) + (voff)[_i]), (PG8_LAS unsigned*)(lds + (bufoff) + ldsw + _i * 8192), 16, 0, 0); } while (0)
#define PG8_LDA(dst, b, h) do { _Pragma("unroll") for (int m = 0; m < 4; ++m) _Pragma("unroll") for (int k = 0; k < 2; ++k) dst[m][k] = *(const PG8_LAS bf16x8*)(lds + PG8_SA(b, h) + aoff + m * 2048 + k * 1024); } while (0)
#define PG8_LDB(dst, b, h) do { _Pragma("unroll") for (int n = 0; n < 2; ++n) _Pragma("unroll") for (int k = 0; k < 2; ++k) dst[n][k] = *(const PG8_LAS bf16x8*)(lds + PG8_SB(b, h) + boff + n * 2048 + k * 1024); } while (0)
#define PG8_MMA(ai, bj, At, Bt) do { __builtin_amdgcn_s_setprio(1); _Pragma("unroll") for (int m = 0; m < 4; ++m) _Pragma("unroll") for (int n = 0; n < 2; ++n) _Pragma("unroll") for (int k = 0; k < 2; ++k) \
        acc[ai][bj][m][n] = __builtin_amdgcn_mfma_f32_16x16x32_bf16(Bt[n][k], At[m][k], acc[ai][bj][m][n], 0, 0, 0); __builtin_amdgcn_s_setprio(0); } while (0)
#define PG8_WAIT_V(n) asm volatile("s_waitcnt vmcnt(" #n ")" ::: "memory")
#define PG8_WAIT_L(n) asm volatile("s_waitcnt lgkmcnt(" #n ")" ::: "memory")
#define PG8_BAR __builtin_amdgcn_s_barrier()
#define PG8_SCHED __builtin_amdgcn_sched_barrier(0)
    Unit cur, nxt; int ui = 0;
    if (!S.next(0, cur)) return;
    f32x4 acc[2][2][4][2];
#pragma unroll
    for (int a = 0; a < 2; ++a)
#pragma unroll
        for (int b = 0; b < 2; ++b)
#pragma unroll
            for (int m = 0; m < 4; ++m)
#pragma unroll
                for (int n = 0; n < 2; ++n) acc[a][b][m][n] = (f32x4){0.f, 0.f, 0.f, 0.f};
    bf16x8 At[4][2], B0[2][2], B1[2][2];
    const char* cA = (const char*)g.A + (size_t)cur.pm * tstepA; const char* cB = (const char*)g.Bt + (size_t)cur.pn * tstepB;
    S.a_ready(cur);
    if constexpr (SP2) {
        PG8_STAGE(PG8_SB(0, 0), cB, voffB); PG8_STAGE(PG8_SB(0, 1), cB + hstepB, voffB); PG8_STAGE(PG8_SA(0, 0), cA, voffA); PG8_STAGE(PG8_SA(0, 1), cA + hstepA, voffA);
        if (wr == 1) PG8_BAR;
        PG8_WAIT_V(2); PG8_BAR;
        PG8_STAGE(PG8_SB(1, 0), cB + kstep, voffB); PG8_STAGE(PG8_SA(1, 0), cA + kstep, voffA); PG8_STAGE(PG8_SB(1, 1), cB + hstepB + kstep, voffB);
        PG8_WAIT_V(6); PG8_BAR;
    } else {
        PG8_STAGE(PG8_SB(0, 0), cB, voffB); PG8_STAGE(PG8_SA(0, 0), cA, voffA); PG8_STAGE(PG8_SB(0, 1), cB + hstepB, voffB); PG8_STAGE(PG8_SA(0, 1), cA + hstepA, voffA);
        if (wr == 1) PG8_BAR;
        PG8_WAIT_V(4); PG8_BAR;
        PG8_STAGE(PG8_SB(1, 0), cB + kstep, voffB); PG8_STAGE(PG8_SA(1, 0), cA + kstep, voffA); PG8_STAGE(PG8_SB(1, 1), cB + hstepB + kstep, voffB);
        PG8_WAIT_V(6); PG8_BAR;
    }
    for (;;) {
        const bool has_next = S.next(ui + 1, nxt);
        const char* nA = has_next ? (const char*)g.A + (size_t)nxt.pm * tstepA : cA; const char* nB = has_next ? (const char*)g.Bt + (size_t)nxt.pn * tstepB : cB;
        for (int t = 0; t < nt; t += 2) {
            const bool last = (t == nt - 2);
            const char* a1 = cA + (size_t)(t + 1) * kstep;
            const char* a2 = last ? nA : cA + (size_t)(t + 2) * kstep; const char* b2 = last ? nB : cB + (size_t)(t + 2) * kstep;
            const char* a3 = a2 + kstep; const char* b3 = b2 + kstep;
            if (last && has_next) S.a_ready(nxt);
            if constexpr (SP2) {
            PG8_LDB(B0, 0, 0); PG8_LDB(B1, 0, 1); PG8_SCHED; PG8_LDA(At, 0, 0); PG8_STAGE(PG8_SA(1, 1), a1 + hstepA, voffA);
            PG8_WAIT_V(8); PG8_WAIT_L(0); PG8_BAR; PG8_MMA(0, 0, At, B0); PG8_MMA(0, 1, At, B1); PG8_BAR; PG8_SCHED;
            PG8_LDA(At, 0, 1); PG8_STAGE(PG8_SB(0, 0), b2, voffB); PG8_STAGE(PG8_SB(0, 1), b2 + hstepB, voffB); PG8_STAGE(PG8_SA(0, 0), a2, voffA);
            PG8_WAIT_V(8); PG8_WAIT_L(0); PG8_BAR; PG8_MMA(1, 0, At, B0); PG8_MMA(1, 1, At, B1); PG8_BAR; PG8_SCHED;
            PG8_LDB(B0, 1, 0); PG8_LDB(B1, 1, 1); PG8_SCHED; PG8_LDA(At, 1, 0); PG8_STAGE(PG8_SA(0, 1), a2 + hstepA, voffA);
            PG8_WAIT_V(8); PG8_WAIT_L(0); PG8_BAR; PG8_MMA(0, 0, At, B0); PG8_MMA(0, 1, At, B1); PG8_BAR; PG8_SCHED;
            PG8_LDA(At, 1, 1); PG8_STAGE(PG8_SB(1, 0), b3, voffB); PG8_STAGE(PG8_SB(1, 1), b3 + hstepB, voffB); PG8_STAGE(PG8_SA(1, 0), a3, voffA);
            PG8_WAIT_V(8); PG8_WAIT_L(0); PG8_BAR; PG8_MMA(1, 0, At, B0); PG8_MMA(1, 1, At, B1); PG8_BAR; PG8_SCHED;
            } else {
            PG8_LDB(B0, 0, 0); PG8_SCHED; PG8_LDA(At, 0, 0); PG8_STAGE(PG8_SA(1, 1), a1 + hstepA, voffA);
            PG8_WAIT_L(8); PG8_BAR; PG8_WAIT_L(0); PG8_MMA(0, 0, At, B0); PG8_BAR; PG8_SCHED;
            PG8_LDB(B1, 0, 1); PG8_STAGE(PG8_SB(0, 0), b2, voffB);
            PG8_BAR; PG8_WAIT_L(0); PG8_MMA(0, 1, At, B1); PG8_BAR;
            PG8_LDA(At, 0, 1); PG8_STAGE(PG8_SA(0, 0), a2, voffA);
            PG8_BAR; PG8_WAIT_L(0); PG8_MMA(1, 0, At, B0); PG8_BAR; PG8_SCHED;
            PG8_STAGE(PG8_SB(0, 1), b2 + hstepB, voffB);
            PG8_WAIT_V(6); PG8_BAR; PG8_MMA(1, 1, At, B1); PG8_BAR;
            PG8_LDB(B0, 1, 0); PG8_SCHED; PG8_LDA(At, 1, 0); PG8_STAGE(PG8_SA(0, 1), a2 + hstepA, voffA);
            PG8_WAIT_L(8); PG8_BAR; PG8_WAIT_L(0); PG8_MMA(0, 0, At, B0); PG8_BAR; PG8_SCHED;
            PG8_LDB(B1, 1, 1); PG8_STAGE(PG8_SB(1, 0), b3, voffB);
            PG8_BAR; PG8_WAIT_L(0); PG8_MMA(0, 1, At, B1); PG8_BAR;
            PG8_LDA(At, 1, 1); PG8_STAGE(PG8_SA(1, 0), a3, voffA);
            PG8_BAR; PG8_WAIT_L(0); PG8_MMA(1, 0, At, B0); PG8_BAR; PG8_SCHED;
            PG8_STAGE(PG8_SB(1, 1), b3 + hstepB, voffB);
            PG8_WAIT_V(6); PG8_BAR; PG8_MMA(1, 1, At, B1); PG8_BAR;
            }
        }
        if constexpr (ALIGN_EPI) { if (wr == 0) PG8_BAR; }
        if constexpr (!Epi::AFTER_DRAIN) { E(acc, cur, wr, wc, fr, fq); S.done(cur); }
        if (!has_next) break;
#pragma unroll
        for (int a = 0; a < 2; ++a)
#pragma unroll
            for (int b = 0; b < 2; ++b)
#pragma unroll
                for (int m = 0; m < 4; ++m)
#pragma unroll
                    for (int n = 0; n < 2; ++n) acc[a][b][m][n] = (f32x4){0.f, 0.f, 0.f, 0.f};
        cur = nxt; cA = nA; cB = nB; ++ui;
        if constexpr (ALIGN_EPI) { if (wr == 1) PG8_BAR; }
    }
    PG8_WAIT_V(0);
    if constexpr (!ALIGN_EPI) { if (wr == 0) PG8_BAR; }
    PG8_BAR;
    if constexpr (Epi::AFTER_DRAIN) { E.fused(acc, cur, wr, wc, fr, fq, lds, wid, lane); S.done(cur); }
#undef PG8_SA
#undef PG8_SB
#undef PG8_STAGE
#undef PG8_LDA
#undef PG8_LDB
#undef PG8_MMA
#undef PG8_WAIT_V
#undef PG8_WAIT_L
#undef PG8_BAR
#undef PG8_SCHED
}
}


#define XB_TMO      128
#define XB_XCNT(j)  (256  + 64 * (j))
#define XB_XSUB(j)  (1280 + 64 * (j))
#define XB_XGEN(j)  (2304 + 64 * (j))
#define XB_TOP      3328
#define XB_TOPGEN   3392
#define XCD_BAR_WORDS 3456
#define XB_SPIN_CAP (1u << 18)

__device__ __forceinline__ unsigned xb_ld(unsigned* p)              { return __hip_atomic_load(p, __ATOMIC_RELAXED, __HIP_MEMORY_SCOPE_AGENT); }
__device__ __forceinline__ unsigned xb_add(unsigned* p, unsigned v) { return __hip_atomic_fetch_add(p, v, __ATOMIC_RELAXED, __HIP_MEMORY_SCOPE_AGENT); }
__device__ __forceinline__ unsigned xb_xcc_id() { return (unsigned)__builtin_amdgcn_s_getreg((3 << 11) | 20) & 0xFu; }
#define XB_SPIN(cond, bar) do { unsigned _sp = 0; while (cond) { __builtin_amdgcn_s_sleep(1); \
    if ((++_sp & 255u) == 0u) { if (xb_ld(&(bar)[XB_TMO])) break; if (_sp > XB_SPIN_CAP) { atomicAdd(&(bar)[XB_TMO], 1u); break; } } } } while (0)

struct XcdBarrier {
    unsigned* bar; unsigned x;
    volatile __attribute__((address_space(3))) unsigned* st;
};

__device__ __forceinline__ XcdBarrier xcd_barrier_post(unsigned* bar, volatile __attribute__((address_space(3))) unsigned* st) {
    XcdBarrier b; b.bar = bar; b.x = xb_xcc_id(); b.st = st;
    if (threadIdx.x == 0) (void)xb_add(&bar[XB_XCNT(b.x)], 1u);
    return b;
}
__device__ __forceinline__ void xcd_barrier_complete(unsigned* bar, unsigned x, unsigned& nloc, unsigned& nx) {
    const unsigned G = gridDim.x * gridDim.y * gridDim.z;
    unsigned sum, cnt, mine, sp = 0u;
    for (;;) {
        sum = 0u; cnt = 0u; mine = 0u;
#pragma unroll
        for (unsigned j = 0; j < 16; ++j) { const unsigned c = xb_ld(&bar[XB_XCNT(j)]); sum += c; cnt += (c > 0u) ? 1u : 0u; mine = (j == x) ? c : mine; }
        if (sum == G) break;
        __builtin_amdgcn_s_sleep(1);
        if ((++sp & 255u) == 0u) { if (xb_ld(&bar[XB_TMO])) break; if (sp > XB_SPIN_CAP) { atomicAdd(&bar[XB_TMO], 1u); break; } }
    }
    nloc = mine > 0u ? mine : 1u; nx = cnt > 0u ? cnt : 1u;
}

__device__ __forceinline__ void xcd_barrier(const XcdBarrier& b) {
    asm volatile("s_waitcnt vmcnt(0)" ::: "memory");
    __syncthreads();
    if (threadIdx.x == 0) {
        unsigned* bar = b.bar;
        __builtin_amdgcn_s_waitcnt(0);
        unsigned nloc = b.st[0], nx = b.st[1];
        if (nloc == 0u) { xcd_barrier_complete(bar, b.x, nloc, nx); b.st[0] = nloc; b.st[1] = nx; }
        const unsigned old = xb_add(&bar[XB_XSUB(b.x)], 1u);
        const unsigned gen = old / nloc;
        if (old + 1u == (gen + 1u) * nloc) {
            __builtin_amdgcn_fence(__ATOMIC_RELEASE, "agent");
            asm volatile("s_waitcnt vmcnt(0)" ::: "memory");
            const unsigned og = xb_add(&bar[XB_TOP], 1u);
            const unsigned tg = og / nx;
            if (og + 1u == (tg + 1u) * nx) xb_add(&bar[XB_TOPGEN], 1u);
            else XB_SPIN(xb_ld(&bar[XB_TOPGEN]) == tg, bar);
            __builtin_amdgcn_fence(__ATOMIC_ACQUIRE, "agent");
            xb_add(&bar[XB_XGEN(b.x)], 1u);
            asm volatile("s_waitcnt vmcnt(0)" ::: "memory");
        } else {
            XB_SPIN(xb_ld(&bar[XB_XGEN(b.x)]) == gen, bar);
            __builtin_amdgcn_fence(__ATOMIC_ACQUIRE, "agent");
            asm volatile("s_waitcnt vmcnt(0)" ::: "memory");
        }
    }
    __syncthreads();
}

#ifndef REP_P0
#define REP_P0 1
#define REP_P1 1
#define REP_LRU1 1
#define REP_ATT 1
#define REP_P3 1
#define REP_P4 1
#define REP_P5 1
#define REP_SYNC 1
#endif
namespace mk {
using pg8::bf16_t; using pg8::bf16x8; using pg8::f32x4; using pg8::u32x4; using pg8::pk2;
#define LAS __attribute__((address_space(3)))
#define DI __device__ __forceinline__
typedef float f32x16 __attribute__((ext_vector_type(16)));
typedef unsigned u32x2 __attribute__((ext_vector_type(2)));
#define MFMA32(a, b, c) __builtin_amdgcn_mfma_f32_32x32x16_bf16((a), (b), (c), 0, 0, 0)

constexpr int D = 1024, NB = 4, SEQ = 8192;
constexpr int MX = NB * SEQ;
constexpr int M1 = MX + 256;
constexpr int MROW = MX + 16;
constexpr int LDP = 5120;
constexpr int CQ = 0, CK = 1024, CGA = 2048, CXL = 3072, CGL = 4096;
constexpr int CA_LRU = 1024;
constexpr int NCH = 65;
constexpr float EPS = 1e-6f;
constexpr size_t Z_W_BYTES = (size_t)6144 * 1024 * 2, Z_U_BYTES = (size_t)M1 * 1024 * 2, VT_BYTES = (size_t)1024 * M1 * 2;
constexpr size_t OFF_Z = 0;
constexpr size_t OFF_VT = OFF_Z + Z_W_BYTES + Z_U_BYTES;
constexpr size_t OFF_Y = OFF_Z + Z_W_BYTES;
constexpr size_t OFF_P = OFF_VT + VT_BYTES;
constexpr size_t OFF_W2 = OFF_P + (size_t)M1 * LDP * 2;
constexpr size_t OFF_GT = OFF_W2 + (size_t)1024 * 2048 * 2;
constexpr size_t OFF_TOT = OFF_GT + (size_t)2 * 16 * 64 * 64 * 2;
constexpr size_t OFF_CTL = OFF_TOT + (size_t)NB * NCH * 2 * 1024 * 4, CTL_BYTES = 16384;
constexpr size_t WS_END = OFF_CTL + CTL_BYTES;
static_assert((size_t)MX * 1024 * 4 <= Z_U_BYTES + VT_BYTES, "Y overlay");
constexpr int LDS_BYTES = 147456;

struct Args { const float *x, *meta, *pre_g, *post_g, *w_in, *w_out, *att_g, *lru_g, *conv_w, *conv_b, *gaw, *gab, *gxw, *gxb, *lam; float* out; unsigned char* ws; };

DI float wave_sum(float v) {
#pragma unroll
    for (int o = 1; o < 64; o <<= 1) v += __shfl_xor(v, o);
    return v;
}
DI float bflo(unsigned u) { return __uint_as_float(u << 16); }
DI float bfhi(unsigned u) { return __uint_as_float(u & 0xffff0000u); }
DI int crow(int r, int hh) { return (r & 3) + 8 * (r >> 2) + 4 * hh; }
#define LDS_WAIT() asm volatile("s_waitcnt lgkmcnt(0)" ::: "memory")

DI void p0_transpose_item(const float* W, int K, int N, bf16_t* WT, int ldw, int drow0, LAS float* scr, int kb, int nb, int lane) {
    const int k0 = 64 * kb, n0 = 32 * nb;
#pragma unroll 8
    for (int i = 0; i < 32; ++i) { const int kk = 2 * i + (lane >> 5); scr[kk * 33 + (lane & 31)] = W[(size_t)(k0 + kk) * N + n0 + (lane & 31)]; }
    LDS_WAIT();
    const int c = lane & 7;
#pragma unroll
    for (int j = 0; j < 4; ++j) { const int n = (lane >> 3) + 8 * j; const LAS float* s = scr + (8 * c) * 33 + n;
        u32x4 o; o.x = pk2(s[0 * 33], s[1 * 33]); o.y = pk2(s[2 * 33], s[3 * 33]); o.z = pk2(s[4 * 33], s[5 * 33]); o.w = pk2(s[6 * 33], s[7 * 33]);
        *(u32x4*)(WT + (size_t)(drow0 + n) * ldw + k0 + 8 * c) = o; }
    LDS_WAIT();
}
DI void p0_prep(const Args& a, LAS unsigned char* lds, int G, int bid, int wave, int lane) {
    unsigned char* ws = a.ws;
    bf16_t* Z = (bf16_t*)(ws + OFF_Z); bf16_t* W2t = (bf16_t*)(ws + OFF_W2); bf16_t* GT = (bf16_t*)(ws + OFF_GT);
    LAS float* scr = (LAS float*)(lds + wave * 16384);
    const int gw = bid * 8 + wave, NGW = G * 8;
    for (int it = gw; it < 16 * 192; it += NGW) {
        const int kb = it / 192, nb = it % 192, n0 = 32 * nb, seg = n0 >> 10;
        const int dseg = seg == 0 ? 0 : seg == 1 ? 1 : seg == 2 ? 5 : seg - 1;
        p0_transpose_item(a.w_in, 1024, 6144, Z, 1024, dseg * 1024 + (n0 & 1023), scr, kb, nb, lane);
    }
    for (int it = gw; it < 32 * 32; it += NGW) { const int kb = it / 32, nb = it % 32; p0_transpose_item(a.w_out, 2048, 1024, W2t, 2048, 32 * nb, scr, kb, nb, lane); }
    bf16_t* U = Z + (size_t)6144 * 1024;
    f32x4 gv[4];
#pragma unroll
    for (int j = 0; j < 4; ++j) gv[j] = ((const f32x4*)a.pre_g)[64 * j + lane];
    for (int m = gw; m < M1; m += NGW) {
        unsigned long long* o8 = (unsigned long long*)(U + (size_t)m * 1024) + lane;
        const float* src = (m < MX) ? a.x + (size_t)m * 1024 : ((m >= MROW && m < MROW + 16) ? a.meta + (size_t)(m - MROW) * 1024 : nullptr);
        if (src == nullptr) {
#pragma unroll
            for (int j = 0; j < 4; ++j) o8[64 * j] = 0ull;
            continue; }
        const f32x4* xr = (const f32x4*)src + lane;
        f32x4 v[4]; float s = 0.f;
#pragma unroll
        for (int j = 0; j < 4; ++j) { v[j] = xr[64 * j]; s += (v[j].x * v[j].x + v[j].y * v[j].y) + (v[j].z * v[j].z + v[j].w * v[j].w); }
        const float rstd = rsqrtf(wave_sum(s) * (1.f / 1024.f) + EPS);
#pragma unroll
        for (int j = 0; j < 4; ++j) { const f32x4 t = v[j] * rstd * gv[j]; o8[64 * j] = (unsigned long long)pk2(t.x, t.y) | ((unsigned long long)pk2(t.z, t.w) << 32); }
    }
    for (int idx = bid * 512 + wave * 64 + lane; idx < 2 * 16 * 64 * 64; idx += G * 512) {
        const int i = idx & 63, j = (idx >> 6) & 63, n = (idx >> 12) & 15, gate = idx >> 16;
        const float* src = gate ? a.gxw : a.gaw;
        GT[idx] = (bf16_t)(pk2(src[(n * 64 + i) * 64 + j], 0.f) & 0xffffu);
    }
}

struct Sched1 {
    int G, c;
    DI bool next(int i, pg8::Unit& u) const {
        const long L = (long)i * G + c; if (L >= 3096) return false;
        if (L < 2580) {
            constexpr int nM = 129, nN = 20, nwg = 2580;
            int wgid = (int)L; { const int q = nwg / 8, r = nwg % 8, xcd = wgid % 8, off = wgid / 8; wgid = (xcd < r ? xcd * (q + 1) : r * (q + 1) + (xcd - r) * q) + off; }
            const int nig = 8 * nN, gid = wgid / nig, fm = gid * 8, gsz = (nM - fm) < 8 ? (nM - fm) : 8;
            u.pm = 24 + fm + ((wgid % nig) % gsz); u.pn = (wgid % nig) / gsz;
        } else { const int l = (int)L - 2580; u.pm = 20 + l / 129; u.pn = 24 + l % 129; }
        return true;
    }
    DI void a_ready(const pg8::Unit&) const {}
    DI void done(const pg8::Unit&) const {}
};
DI float silu(float v) { return v * __builtin_amdgcn_rcpf(1.f + __expf(-v)); }
struct EpiP {
    static constexpr bool PERM = true, AFTER_DRAIN = false;
    bf16_t* P; bf16_t* VT;
    DI void vt_store(const f32x4 (&acc)[2][2][4][2], const pg8::Unit& u, int wr, int wc, int fr, int fq) const {
#pragma unroll
        for (int ai = 0; ai < 2; ++ai)
#pragma unroll
            for (int m = 0; m < 4; ++m) { const int vcol = (u.pm - 20) * 256 + ai * 128 + wr * 64 + m * 16 + fr, hd = vcol >> 7, d = vcol & 127;
#pragma unroll
                for (int bj = 0; bj < 2; ++bj) { const int tile = ((u.pn - 24) * 256 + bj * 128 + wc * 32) >> 5;
                    const f32x4 v0 = acc[ai][bj][m][0], v1 = acc[ai][bj][m][1];
                    u32x4 w; w.x = pk2(v0[0], v0[1]); w.y = pk2(v0[2], v0[3]); w.z = pk2(v1[0], v1[1]); w.w = pk2(v1[2], v1[3]);
                    *(u32x4*)(VT + ((size_t)(hd * (M1 / 32) + tile) * 128 + d) * 32 + 8 * fq) = w; } }
    }
    DI void operator()(const f32x4 (&acc)[2][2][4][2], const pg8::Unit& u, int wr, int wc, int fr, int fq) const {
        bf16_t* base; size_t ldc; int row0, col0, seg;
        if (u.pm >= 24) { base = P; ldc = LDP; row0 = (u.pm - 24) * 256 + wr * 64 + fr; col0 = u.pn * 256 + wc * 32 + 8 * fq; seg = u.pn >> 2; }
        else { seg = 1; vt_store(acc, u, wr, wc, fr, fq); return; }
        const float sc = (seg == 0) ? 0.08838834764831845f : 1.f;
        const bool act = (seg == 2 || seg == 4);
#pragma unroll
        for (int ai = 0; ai < 2; ++ai)
#pragma unroll
            for (int m = 0; m < 4; ++m) { bf16_t* rowp = base + (size_t)(row0 + ai * 128 + m * 16) * ldc + col0;
#pragma unroll
                for (int bj = 0; bj < 2; ++bj) { f32x4 v0 = acc[ai][bj][m][0] * sc, v1 = acc[ai][bj][m][1] * sc;
                    if (act) { v0 = (f32x4){silu(v0[0]), silu(v0[1]), silu(v0[2]), silu(v0[3])}; v1 = (f32x4){silu(v1[0]), silu(v1[1]), silu(v1[2]), silu(v1[3])}; }
                    u32x4 w; w.x = pk2(v0[0], v0[1]); w.y = pk2(v0[2], v0[3]); w.z = pk2(v1[0], v1[1]); w.w = pk2(v1[2], v1[3]);
                    *(u32x4*)(rowp + bj * 128) = w; } }
    }
};
struct EpiY {
    static constexpr bool PERM = false, AFTER_DRAIN = false;
    float* Y;
    DI void operator()(const f32x4 (&acc)[2][2][4][2], const pg8::Unit& u, int wr, int wc, int fr, int fq) const {
        const int col0 = u.pn * 256 + wc * 32 + 4 * fq;
#pragma unroll
        for (int ai = 0; ai < 2; ++ai)
#pragma unroll
            for (int m = 0; m < 4; ++m) { float* rowp = Y + (size_t)(u.pm * 256 + ai * 128 + wr * 64 + m * 16 + fr) * 1024 + col0;
#pragma unroll
                for (int bj = 0; bj < 2; ++bj)
#pragma unroll
                    for (int n = 0; n < 2; ++n) *(f32x4*)(rowp + bj * 128 + n * 16) = acc[ai][bj][m][n]; }
    }
};
DI void attn_unit(LAS unsigned char* lds, bf16_t* P, const bf16_t* VT, const float* attg, int b, int qt, int wave, int lane, int par, bool dry) {
    const int h = wave, ql = lane & 31, hh = lane >> 5;
    const int m0 = b * SEQ + qt * 32;
    const int pk = 16 * ((ql >> 2) & 1) + 4 * (ql >> 3) + (ql & 3);
    const bf16_t* qp = P + (size_t)(m0 + ql) * LDP + CQ + h * 128 + 8 * hh;
    bf16x8 qf[8];
#pragma unroll
    for (int s = 0; s < 8; ++s) qf[s] = *(const bf16x8*)(qp + 16 * s);
    f32x16 O[4];
#pragma unroll
    for (int dt = 0; dt < 4; ++dt)
#pragma unroll
        for (int r = 0; r < 16; ++r) O[dt][r] = 0.f;
    unsigned dmask = 0u;
#pragma unroll
    for (int r = 0; r < 16; ++r) dmask |= (16 * hh + r < ql) ? (1u << r) : 0u;
    float carry = 1.f;
    const bf16_t* kcol = P + CK + h * 128 + 8 * hh;
    bf16x8 kf[8];
    { const bf16_t* kp = kcol + (size_t)(m0 + pk) * LDP;
#pragma unroll
      for (int s = 0; s < 8; ++s) kf[s] = *(const bf16x8*)(kp + 16 * s); }
    for (int kt = qt;; --kt) {
        const int krow0 = (kt >= 0) ? b * SEQ + kt * 32 : MX;
        const bf16_t* vp = VT + ((size_t)(h * (M1 / 32) + (krow0 >> 5)) * 128 + ql) * 32 + 16 * hh;
        bf16x8 vf[4][2];
#pragma unroll
        for (int dt = 0; dt < 4; ++dt)
#pragma unroll
            for (int s2 = 0; s2 < 2; ++s2) vf[dt][s2] = *(const bf16x8*)(vp + dt * 1024 + 8 * s2);
        f32x16 S;
#pragma unroll
        for (int r = 0; r < 16; ++r) S[r] = 0.f;
#pragma unroll
        for (int s = 0; s < 8; ++s) S = MFMA32(kf[s], qf[s], S);
        { const int krown = (kt >= 1) ? b * SEQ + (kt - 1) * 32 : MX; const bf16_t* kp = kcol + (size_t)(krown + pk) * LDP;
#pragma unroll
          for (int s = 0; s < 8; ++s) kf[s] = *(const bf16x8*)(kp + 16 * s); }
        const unsigned vm = (kt == qt) ? dmask : (kt < 0 ? (hh ? 0xffffu : 0u) : 0xffffu);
        float om[16], be[16];
#pragma unroll
        for (int r = 0; r < 16; ++r) {
            const float z = fminf(S[r], 80.f), e = __expf(z), rc = __builtin_amdgcn_rcpf(1.f + e);
            const bool v = (vm >> r) & 1u;
            om[r] = v ? rc : 1.f; be[r] = v ? e * rc : 0.f; }
        const float G = ((om[0] * om[1]) * (om[2] * om[3])) * ((om[4] * om[5]) * (om[6] * om[7])) * (((om[8] * om[9]) * (om[10] * om[11])) * ((om[12] * om[13]) * (om[14] * om[15])));
        const float PG = __shfl_xor(G, 32);
        float sf = hh ? carry : carry * PG;
        carry = carry * (G * PG);
        float w[16];
#pragma unroll
        for (int r = 15; r >= 0; --r) { w[r] = be[r] * sf; sf *= om[r]; }
        bf16x8 wf[2];
#pragma unroll
        for (int s2 = 0; s2 < 2; ++s2) { u32x4 t; t.x = pk2(w[8 * s2], w[8 * s2 + 1]); t.y = pk2(w[8 * s2 + 2], w[8 * s2 + 3]); t.z = pk2(w[8 * s2 + 4], w[8 * s2 + 5]); t.w = pk2(w[8 * s2 + 6], w[8 * s2 + 7]);
            wf[s2] = __builtin_bit_cast(bf16x8, t); }
#pragma unroll
        for (int dt = 0; dt < 4; ++dt)
#pragma unroll
            for (int s2 = 0; s2 < 2; ++s2) O[dt] = MFMA32(vf[dt][s2], wf[s2], O[dt]);
        if (kt < 0 || __ballot(carry >= 1e-38f) == 0ull) break;
    }
    float ssq = 0.f;
#pragma unroll
    for (int dt = 0; dt < 4; ++dt)
#pragma unroll
        for (int r = 0; r < 16; ++r) ssq += O[dt][r] * O[dt][r];
    ssq += __shfl_xor(ssq, 32);
    LAS float* red = (LAS float*)lds + par * 256;
    if (hh == 0) red[wave * 32 + ql] = ssq;
    __syncthreads();
    float tot = 0.f;
#pragma unroll
    for (int w8 = 0; w8 < 8; ++w8) tot += red[w8 * 32 + ql];
    const float rstd = rsqrtf(tot * (1.f / 1024.f) + EPS);
    bf16_t* orow = P + (size_t)(m0 + ql) * LDP;
#pragma unroll
    for (int dt = 0; dt < 4; ++dt)
#pragma unroll
        for (int g = 0; g < 4; ++g) {
            const int c = h * 128 + dt * 32 + 8 * g + 4 * hh;
            const f32x4 gg = *(const f32x4*)(attg + c);
            const u32x2 sg = *(const u32x2*)(orow + CGA + c);
            u32x2 o;
            o.x = pk2(O[dt][4 * g] * rstd * gg.x * bflo(sg.x), O[dt][4 * g + 1] * rstd * gg.y * bfhi(sg.x));
            o.y = pk2(O[dt][4 * g + 2] * rstd * gg.z * bflo(sg.y), O[dt][4 * g + 3] * rstd * gg.w * bfhi(sg.y));
            if (!dry) *(u32x2*)(orow + CQ + c) = o; }
}

DI void lru_load_x(u32x4 (&xr)[7], const bf16_t* P, int b, int tpos0, int tq, int cc0) {
#pragma unroll
    for (int k = 0; k < 7; ++k) { const int tp = tpos0 + 4 * tq - 3 + k; const int row = tp >= 0 ? b * SEQ + tp : (tp >= -32 ? MX + 32 + tp : MX);
        xr[k] = *(const u32x4*)(P + (size_t)row * LDP + CXL + cc0); }
}
template <int PASS>
DI void lru_unit(LAS unsigned char* lds, bf16_t* P, const bf16_t* GT, const Args& a, float* TOT, int b, int c, int wave, int lane) {
    const int ql = lane & 31, hh = lane >> 5, chq = lane & 7, tq = lane >> 3;
    LAS float* xcs = (LAS float*)(lds + 4096 + wave * 8704);
    LAS float* cin = (LAS float*)(lds + 4096 + 8 * 8704);
    const int ntiles = (c == 0) ? 1 : 4, nit = 2 * ntiles;
    const int tbase = (c == 0) ? -32 : (c - 1) * 128;
    u32x4 xr[7];
    lru_load_x(xr, P, b, tbase, tq, (2 * wave) * 64 + 8 * chq);
    if (PASS == 2) {
        const int t = wave * 64 + lane; const float* tp = TOT + (size_t)(b * NCH) * 2048 + t;
        float s0 = 0.f, s1 = 0.f; int cc = 0;
        for (; cc + 16 <= c; cc += 16) { float A0[16], H0[16], A1[16], H1[16];
#pragma unroll
            for (int j = 0; j < 16; ++j) { const float* q = tp + (size_t)(cc + j) * 2048; A0[j] = q[0]; H0[j] = q[1024]; A1[j] = q[512]; H1[j] = q[1536]; }
#pragma unroll
            for (int j = 0; j < 16; ++j) { s0 = A0[j] * s0 + H0[j]; s1 = A1[j] * s1 + H1[j]; } }
        for (; cc < c; ++cc) { const float* q = tp + (size_t)cc * 2048; s0 = q[0] * s0 + q[1024]; s1 = q[512] * s1 + q[1536]; }
        cin[t] = s0; cin[t + 512] = s1;
        __syncthreads();
    }
    float cwr[4][8], cbr[8], gabv[2], gxbv[2], lsl8[2], st[2], At[2];
#pragma unroll 1
    for (int it = 0; it < nit; ++it) {
        const int nbk = it / ntiles, ti = it - nbk * ntiles, n = 2 * wave + nbk, cc0 = n * 64 + 8 * chq;
        const int tpos0 = tbase + ti * 32;
        if (ti == 0) {
#pragma unroll
            for (int jj = 0; jj < 4; ++jj) { const f32x4 t0 = *(const f32x4*)(a.conv_w + jj * 1024 + cc0), t1 = *(const f32x4*)(a.conv_w + jj * 1024 + cc0 + 4);
                cwr[jj][0] = t0.x; cwr[jj][1] = t0.y; cwr[jj][2] = t0.z; cwr[jj][3] = t0.w; cwr[jj][4] = t1.x; cwr[jj][5] = t1.y; cwr[jj][6] = t1.z; cwr[jj][7] = t1.w; }
            { const f32x4 t0 = *(const f32x4*)(a.conv_b + cc0), t1 = *(const f32x4*)(a.conv_b + cc0 + 4);
                cbr[0] = t0.x; cbr[1] = t0.y; cbr[2] = t0.z; cbr[3] = t0.w; cbr[4] = t1.x; cbr[5] = t1.y; cbr[6] = t1.z; cbr[7] = t1.w; }
#pragma unroll
            for (int nt = 0; nt < 2; ++nt) { const int ch = n * 64 + nt * 32 + ql; gabv[nt] = a.gab[ch]; gxbv[nt] = a.gxb[ch];
                const float l = a.lam[ch]; lsl8[nt] = 8.f * (fminf(l, 0.f) - log1pf(__expf(-fabsf(l))));
                st[nt] = (PASS == 2) ? cin[ch] : 0.f; At[nt] = 1.f; }
        }
        bf16x8 bfr[2][2][4];
#pragma unroll
        for (int gate = 0; gate < 2; ++gate)
#pragma unroll
            for (int nt = 0; nt < 2; ++nt)
#pragma unroll
                for (int s = 0; s < 4; ++s) bfr[gate][nt][s] = *(const bf16x8*)(GT + ((size_t)((gate * 16 + n) * 64 + nt * 32 + ql)) * 64 + 16 * s + 8 * hh);
#pragma unroll
        for (int i = 0; i < 4; ++i) { float xc[8];
#pragma unroll
            for (int e = 0; e < 8; ++e) { float acc = cbr[e];
#pragma unroll
                for (int jj = 0; jj < 4; ++jj) { const unsigned uw = xr[i + jj][e >> 1]; acc += ((e & 1) ? bfhi(uw) : bflo(uw)) * cwr[jj][e]; }
                xc[e] = acc; }
            LAS float* dst = xcs + (4 * tq + i) * 68 + 8 * chq;
            *(LAS f32x4*)dst = (f32x4){xc[0], xc[1], xc[2], xc[3]}; *(LAS f32x4*)(dst + 4) = (f32x4){xc[4], xc[5], xc[6], xc[7]}; }
        if (it + 1 < nit) { const int nb2 = (it + 1) / ntiles, ti2 = (it + 1) - nb2 * ntiles; lru_load_x(xr, P, b, tbase + ti2 * 32, tq, (2 * wave + nb2) * 64 + 8 * chq); }
        LDS_WAIT();
        bf16x8 af[4];
#pragma unroll
        for (int s = 0; s < 4; ++s) { const f32x4 v0 = *(const LAS f32x4*)(xcs + ql * 68 + 16 * s + 8 * hh), v1 = *(const LAS f32x4*)(xcs + ql * 68 + 16 * s + 8 * hh + 4);
            u32x4 t; t.x = pk2(v0.x, v0.y); t.y = pk2(v0.z, v0.w); t.z = pk2(v1.x, v1.y); t.w = pk2(v1.z, v1.w); af[s] = __builtin_bit_cast(bf16x8, t); }
#pragma unroll
        for (int nt = 0; nt < 2; ++nt) {
            f32x16 ga, gx;
#pragma unroll
            for (int r = 0; r < 16; ++r) { ga[r] = 0.f; gx[r] = 0.f; }
#pragma unroll
            for (int s = 0; s < 4; ++s) { ga = MFMA32(af[s], bfr[0][nt][s], ga); gx = MFMA32(af[s], bfr[1][nt][s], gx); }
            float av[16], bv[16];
#pragma unroll
            for (int r = 0; r < 16; ++r) {
                const int tok = crow(r, hh);
                const float ra = __builtin_amdgcn_rcpf(1.f + __expf(-(ga[r] + gabv[nt]))), ix = __builtin_amdgcn_rcpf(1.f + __expf(-(gx[r] + gxbv[nt])));
                const float la = ra * lsl8[nt], x2 = 2.f * la;
                float av_ = __expf(la);
                const float m2 = (x2 > -0.2f) ? -x2 * (1.f + x2 * (0.5f + x2 * (0.16666667f + x2 * (0.041666668f + x2 * (0.0083333338f + x2 * 0.0013888889f))))) : 1.f - av_ * av_;
                float bv_ = __builtin_amdgcn_sqrtf(m2) * ix * xcs[tok * 68 + nt * 32 + ql];
                if (c == 0 && tok < 16) { av_ = 1.f; bv_ = 0.f; }
                av[r] = av_; bv[r] = bv_; }
            float Ag[4], Bg[4], PA[4], PB[4];
#pragma unroll
            for (int g = 0; g < 4; ++g) { float A_ = 1.f, B_ = 0.f;
#pragma unroll
                for (int i = 0; i < 4; ++i) { B_ = av[4 * g + i] * B_ + bv[4 * g + i]; A_ *= av[4 * g + i]; }
                Ag[g] = A_; Bg[g] = B_; }
#pragma unroll
            for (int g = 0; g < 4; ++g) { PA[g] = __shfl_xor(Ag[g], 32); PB[g] = __shfl_xor(Bg[g], 32); }
            float s = st[nt], atot = At[nt], start[4];
#pragma unroll
            for (int g = 0; g < 4; ++g) {
                const float A0 = hh ? PA[g] : Ag[g], B0 = hh ? PB[g] : Bg[g], A1 = hh ? Ag[g] : PA[g], B1 = hh ? Bg[g] : PB[g];
                const float s0 = s; s = A0 * s + B0; const float s1 = s; s = A1 * s + B1;
                start[g] = hh ? s1 : s0; atot *= A0 * A1; }
            st[nt] = s; At[nt] = atot;
            if (PASS == 2) {
                const int ch = n * 64 + nt * 32 + ql;
#pragma unroll
                for (int g = 0; g < 4; ++g) { float hc = start[g];
#pragma unroll
                    for (int i = 0; i < 4; ++i) { hc = av[4 * g + i] * hc + bv[4 * g + i];
                        P[(size_t)(b * SEQ + tpos0 + 8 * g + 4 * hh + i) * LDP + CA_LRU + ch] = (bf16_t)(pk2(hc, 0.f) & 0xffffu); } }
            }
        }
        LDS_WAIT();
        if (PASS == 1 && ti == ntiles - 1 && hh == 0) {
#pragma unroll
            for (int nt = 0; nt < 2; ++nt) { const int ch = n * 64 + nt * 32 + ql; float* tp = TOT + (size_t)(b * NCH + c) * 2048 + ch; tp[0] = At[nt]; tp[1024] = st[nt]; }
        }
    }
    if (PASS == 2) {
        __syncthreads();
        f32x4 gg[4];
#pragma unroll
        for (int e4 = 0; e4 < 4; ++e4) gg[e4] = *(const f32x4*)(a.lru_g + 16 * lane + 4 * e4);
#pragma unroll 1
        for (int r4 = 0; r4 < 4; ++r4) {
            u32x4 h0[4], h1[4], s0[4], s1[4];
#pragma unroll
            for (int k = 0; k < 4; ++k) { const int row = b * SEQ + (c - 1) * 128 + wave * 16 + r4 * 4 + k;
                const bf16_t* hp = P + (size_t)row * LDP + CA_LRU + 16 * lane; const bf16_t* gp = P + (size_t)row * LDP + CGL + 16 * lane;
                h0[k] = *(const u32x4*)hp; h1[k] = *(const u32x4*)(hp + 8); s0[k] = *(const u32x4*)gp; s1[k] = *(const u32x4*)(gp + 8); }
#pragma unroll
            for (int k = 0; k < 4; ++k) { const int row = b * SEQ + (c - 1) * 128 + wave * 16 + r4 * 4 + k;
                bf16_t* hp = P + (size_t)row * LDP + CA_LRU + 16 * lane;
                float hv[16], sv[16];
#pragma unroll
                for (int e = 0; e < 4; ++e) { hv[2 * e] = bflo(h0[k][e]); hv[2 * e + 1] = bfhi(h0[k][e]); hv[8 + 2 * e] = bflo(h1[k][e]); hv[8 + 2 * e + 1] = bfhi(h1[k][e]);
                    sv[2 * e] = bflo(s0[k][e]); sv[2 * e + 1] = bfhi(s0[k][e]); sv[8 + 2 * e] = bflo(s1[k][e]); sv[8 + 2 * e + 1] = bfhi(s1[k][e]); }
                float ss = 0.f;
#pragma unroll
                for (int e = 0; e < 16; ++e) ss += hv[e] * hv[e];
                const float rstd = rsqrtf(wave_sum(ss) * (1.f / 1024.f) + EPS);
                float ov[16];
#pragma unroll
                for (int e4 = 0; e4 < 4; ++e4) {
                    ov[4 * e4] = hv[4 * e4] * rstd * gg[e4].x * sv[4 * e4]; ov[4 * e4 + 1] = hv[4 * e4 + 1] * rstd * gg[e4].y * sv[4 * e4 + 1];
                    ov[4 * e4 + 2] = hv[4 * e4 + 2] * rstd * gg[e4].z * sv[4 * e4 + 2]; ov[4 * e4 + 3] = hv[4 * e4 + 3] * rstd * gg[e4].w * sv[4 * e4 + 3]; }
                u32x4 o0, o1;
#pragma unroll
                for (int e = 0; e < 4; ++e) { o0[e] = pk2(ov[2 * e], ov[2 * e + 1]); o1[e] = pk2(ov[8 + 2 * e], ov[8 + 2 * e + 1]); }
                *(u32x4*)hp = o0; *(u32x4*)(hp + 8) = o1; }
        }
    }
}

DI void p5_final(const Args& a, const float* Y, int G, int bid, int wave, int lane) {
    f32x4 gv[4];
#pragma unroll
    for (int j = 0; j < 4; ++j) gv[j] = ((const f32x4*)a.post_g)[64 * j + lane];
    for (int m = bid * 8 + wave; m < MX; m += G * 8) {
        const f32x4* yr = (const f32x4*)(Y + (size_t)m * 1024) + lane; const f32x4* xr = (const f32x4*)(a.x + (size_t)m * 1024) + lane; f32x4* orow = (f32x4*)(a.out + (size_t)m * 1024) + lane;
        f32x4 v[4], xv[4]; float s = 0.f;
#pragma unroll
        for (int j = 0; j < 4; ++j) { v[j] = yr[64 * j]; xv[j] = xr[64 * j]; s += (v[j].x * v[j].x + v[j].y * v[j].y) + (v[j].z * v[j].z + v[j].w * v[j].w); }
        const float rstd = rsqrtf(wave_sum(s) * (1.f / 1024.f) + EPS);
#pragma unroll
        for (int j = 0; j < 4; ++j) orow[64 * j] = xv[j] + v[j] * rstd * gv[j];
    }
}

__global__ void __launch_bounds__(512, 2) hymba_fwd(Args a) {
    extern __shared__ __attribute__((aligned(16))) unsigned char lds_raw[];
    LAS unsigned char* lds = (LAS unsigned char*)lds_raw;
    cg::grid_group grid = cg::this_grid();
    const int tid = threadIdx.x, lane = tid & 63, wave = __builtin_amdgcn_readfirstlane(tid >> 6), G = gridDim.x, bid = blockIdx.x;
    unsigned char* ws = a.ws;
    bf16_t* Z = (bf16_t*)(ws + OFF_Z); bf16_t* VT = (bf16_t*)(ws + OFF_VT); bf16_t* P = (bf16_t*)(ws + OFF_P); bf16_t* W2t = (bf16_t*)(ws + OFF_W2);
    bf16_t* GT = (bf16_t*)(ws + OFF_GT); float* TOT = (float*)(ws + OFF_TOT); float* Y = (float*)(ws + OFF_Y);

    if (tid < 16) ((LAS unsigned*)(lds + 131072))[tid] = 0u;
    __syncthreads();
    const XcdBarrier bar = xcd_barrier_post((unsigned*)(ws + OFF_CTL), (volatile LAS unsigned*)(lds + 131072));
    if (a.ws == nullptr) grid.sync();
#define GRID_BAR() xcd_barrier(bar)
    for (int rep = 0; rep < REP_P0; ++rep) { p0_prep(a, lds, G, bid, wave, lane); __syncthreads(); }
    GRID_BAR();
    {
        pg8::Gemm g{Z, Z, 0, 0, 1024, 1024, 1024}; Sched1 S{G, bid}; EpiP E{P, VT};
        for (int rep = 0; rep < REP_P1; ++rep) pg8::gemm_phase<EpiP, Sched1, true, true>(lds, g, S, E);
    }
    GRID_BAR();
    {
        for (int rep = 0; rep < REP_LRU1; ++rep) for (int u = bid; u < NB * 64; u += G) lru_unit<1>(lds, P, GT, a, TOT, u >> 6, u & 63, wave, lane);
        __syncthreads();
        int par = 0;
        for (int rep = 0; rep < REP_ATT; ++rep) for (int u = bid; u < NB * 256; u += G, par ^= 1) attn_unit(lds, P, VT, a.att_g, u >> 8, u & 255, wave, lane, par, rep + 1 < REP_ATT + (int)(a.ws == nullptr));
    }
    GRID_BAR();
    {
        for (int rep = 0; rep < REP_P3; ++rep) for (int u = bid; u < NB * 64; u += G) { lru_unit<2>(lds, P, GT, a, TOT, u >> 6, 1 + (u & 63), wave, lane); __syncthreads(); }
    }
    GRID_BAR();
    {
        pg8::Gemm g{P, W2t, MX, 1024, 2048, LDP, 2048}; pg8::StaticOrder S; S.init(MX, 1024, G, bid); EpiY E{Y};
        for (int rep = 0; rep < REP_P4; ++rep) pg8::gemm_phase<EpiY, pg8::StaticOrder, true, true>(lds, g, S, E);
    }
    GRID_BAR();
    for (int rep = 1; rep < REP_SYNC; ++rep) GRID_BAR();
    for (int rep = 0; rep < REP_P5; ++rep) p5_final(a, Y, G, bid, wave, lane);
}
}

extern "C" void kernel_launch(void* const* d_in, const int* in_sizes, int n_in, void* d_out, int out_size, void* d_ws, size_t ws_size, hipStream_t stream) {
    static int grid = 0;
    if (grid == 0) {
        if (n_in != 15 || out_size != mk::MX * 1024 || ws_size < mk::WS_END) { fprintf(stderr, "kernel_launch: unexpected shapes (n_in %d, out %d, ws %zu, need %zu)\n", n_in, out_size, ws_size, (size_t)mk::WS_END); grid = -1; return; }
        int dev = 0, cus = 0, per_cu = 0;
        (void)hipGetDevice(&dev); (void)hipDeviceGetAttribute(&cus, hipDeviceAttributeMultiprocessorCount, dev);
        if (hipFuncSetAttribute((const void*)mk::hymba_fwd, hipFuncAttributeMaxDynamicSharedMemorySize, mk::LDS_BYTES) != hipSuccess) { fprintf(stderr, "kernel_launch: hipFuncSetAttribute failed\n"); grid = -1; return; }
        if (hipOccupancyMaxActiveBlocksPerMultiprocessor(&per_cu, (const void*)mk::hymba_fwd, 512, mk::LDS_BYTES) != hipSuccess || per_cu < 1) { fprintf(stderr, "kernel_launch: occupancy query says %d\n", per_cu); per_cu = 1; }
        (void)hipGetLastError();
        grid = cus;
    }
    if (grid < 0) return;
    mk::Args a{};
    a.x = (const float*)d_in[0]; a.meta = (const float*)d_in[1]; a.pre_g = (const float*)d_in[2]; a.post_g = (const float*)d_in[3]; a.w_in = (const float*)d_in[4]; a.w_out = (const float*)d_in[5];
    a.att_g = (const float*)d_in[6]; a.lru_g = (const float*)d_in[7]; a.conv_w = (const float*)d_in[8]; a.conv_b = (const float*)d_in[9]; a.gaw = (const float*)d_in[10]; a.gab = (const float*)d_in[11];
    a.gxw = (const float*)d_in[12]; a.gxb = (const float*)d_in[13]; a.lam = (const float*)d_in[14]; a.out = (float*)d_out; a.ws = (unsigned char*)d_ws;
    if (hipMemsetAsync((char*)d_ws + mk::OFF_CTL, 0, mk::CTL_BYTES, stream) != hipSuccess) { fprintf(stderr, "kernel_launch: memset failed\n"); return; }
    void* args[] = {&a};
    hipError_t e = hipLaunchCooperativeKernel((const void*)mk::hymba_fwd, dim3(grid), dim3(512), args, mk::LDS_BYTES, stream);
    if (e != hipSuccess) fprintf(stderr, "kernel_launch: cooperative launch failed: %s (grid %d)\n", hipGetErrorString(e), grid);
}
```
